# Optimizing an MI355X kernel written in HIP

```python
import math
import jax, jax.numpy as jnp
from jax import lax
import numpy as np

D_MODEL = 1024
BATCH = 16
SEQ = 2048
DEPTH = 4

MIX_WIDTH = D_MODEL
M_WIDTH = MIX_WIDTH // 2
A_WIDTH = MIX_WIDTH - M_WIDTH
M_HEADS = 4
M_HEAD_DIM = M_WIDTH // M_HEADS
A_HEADS = 4
A_V_DIM = A_WIDTH // A_HEADS
A_QK_DIM = A_V_DIM // 2
CONV_K = 4
CHUNK = 64
Q_BLOCK = 128
ROPE_THETA = 10000.0
FFN_HIDDEN = -(-8 * D_MODEL // (3 * 256)) * 256
EPS = 1e-6
HEAD_EPS = 1e-5
SPLITS = [2 * M_WIDTH,
          3 * M_WIDTH,
          4 * M_WIDTH,
          4 * M_WIDTH + 2 * M_HEADS,
          4 * M_WIDTH + 2 * M_HEADS + A_WIDTH,
          4 * M_WIDTH + 2 * M_HEADS + 2 * A_WIDTH]
IN_WIDTH = 4 * M_WIDTH + 2 * M_HEADS + 3 * A_WIDTH

kernel_name = "hymba_mlstm_diffattn_trunk"


def rmsnorm(x, g, eps=EPS):
    xf = x.astype(jnp.float32)
    y = xf * lax.rsqrt(jnp.mean(xf * xf, axis=-1, keepdims=True) + eps)
    return (y * g.astype(jnp.float32)).astype(x.dtype)


def causal_conv(u, w, b):
    k_len = w.shape[0]
    s = u.shape[1]
    up = jnp.pad(u, ((0, 0), (k_len - 1, 0), (0, 0)))
    y = up[:, 0:s] * w[0]
    for j in range(1, k_len):
        y = y + up[:, j:j + s] * w[j]
    return y + b


def rope_tables(seq, dim):
    pos = jnp.arange(seq, dtype=jnp.float32)
    inv = ROPE_THETA ** (-jnp.arange(0, dim, 2, dtype=jnp.float32) / dim)
    ang = pos[:, None] * inv[None, :]
    return jnp.cos(ang), jnp.sin(ang)


def apply_rope(t, cos, sin):
    c = cos[:, None, None, :].astype(t.dtype)
    s = sin[:, None, None, :].astype(t.dtype)
    t1, t2 = jnp.split(t, 2, axis=-1)
    return jnp.concatenate([t1 * c - t2 * s, t2 * c + t1 * s], axis=-1)


def mlstm_chunkwise(q, k, v, i_pre, log_f):
    b_sz, n_h, s_len, d = q.shape
    nc = s_len // CHUNK
    to_c = lambda t: jnp.moveaxis(t.reshape(b_sz, n_h, nc, CHUNK, *t.shape[3:]), 2, 0)
    qc, kc, vc, ic, fc = to_c(q), to_c(k), to_c(v), to_c(i_pre), to_c(log_f)
    mask = jnp.tril(jnp.ones((CHUNK, CHUNK), dtype=bool))

    def step(carry, inp):
        c_st, n_st, m_st = carry
        qq, kk, vv, ii, lf = inp
        bcum = jnp.cumsum(lf, axis=-1)
        dlog = bcum[..., :, None] - bcum[..., None, :] + ii[..., None, :]
        dlog = jnp.where(mask, dlog, -jnp.inf)
        inter = bcum + m_st[..., None]
        m_t = jnp.maximum(inter, jnp.max(dlog, axis=-1))
        w_intra = jnp.exp(dlog - m_t[..., None])
        w_inter = jnp.exp(inter - m_t)
        sc = jnp.einsum('bhtd,bhsd->bhts', qq, kk) * w_intra
        num = jnp.einsum('bhts,bhse->bhte', sc, vv) + \
            w_inter[..., None] * jnp.einsum('bhtd,bhed->bhte', qq, c_st)
        den = jnp.sum(sc, axis=-1) + w_inter * jnp.einsum('bhtd,bhd->bht', qq, n_st)
        h = num / jnp.maximum(jnp.abs(den), jnp.exp(-m_t))[..., None]
        b_last = bcum[..., -1]
        g = b_last[..., None] - bcum + ii
        m_new = jnp.maximum(b_last + m_st, jnp.max(g, axis=-1))
        ws = jnp.exp(g - m_new[..., None])
        decay = jnp.exp(b_last + m_st - m_new)
        c_new = decay[..., None, None] * c_st + jnp.einsum('bhs,bhse,bhsd->bhed', ws, vv, kk)
        n_new = decay[..., None] * n_st + jnp.einsum('bhs,bhsd->bhd', ws, kk)
        return (c_new, n_new, m_new), h

    init = (jnp.zeros((b_sz, n_h, d, d), jnp.float32),
            jnp.zeros((b_sz, n_h, d), jnp.float32),
            jnp.zeros((b_sz, n_h), jnp.float32))
    _, hs = lax.scan(step, init, (qc, kc, vc, ic, fc))
    return jnp.moveaxis(hs, 0, 2).reshape(b_sz, n_h, s_len, d)


def mlstm_mixer(qk_raw, v_raw, o_raw, gate_pre, conv_w, conv_b, g_head):
    b_sz, s_len, _ = v_raw.shape
    qk = jax.nn.silu(causal_conv(qk_raw, conv_w, conv_b))
    q, k = jnp.split(qk, 2, axis=-1)
    heads = lambda t: t.reshape(b_sz, s_len, M_HEADS, M_HEAD_DIM).transpose(0, 2, 1, 3).astype(jnp.float32)
    q = heads(q)
    k = heads(k) * (M_HEAD_DIM ** -0.5)
    v = heads(v_raw)
    i_pre, f_pre = jnp.split(gate_pre.astype(jnp.float32), 2, axis=-1)
    i_pre = i_pre.transpose(0, 2, 1)
    log_f = jax.nn.log_sigmoid(f_pre).transpose(0, 2, 1)
    h = mlstm_chunkwise(q, k, v, i_pre, log_f).transpose(0, 2, 1, 3)
    h = rmsnorm(h, g_head.reshape(M_HEADS, M_HEAD_DIM), HEAD_EPS)
    return jax.nn.sigmoid(o_raw) * h.reshape(b_sz, s_len, M_WIDTH).astype(o_raw.dtype)


def diff_attention_mixer(q_raw, k_raw, v_raw, cos, sin, lam, lam_init, g_head):
    b_sz, s_len, _ = v_raw.shape
    q = apply_rope(q_raw.reshape(b_sz, s_len, A_HEADS, 2, A_QK_DIM), cos, sin)
    k = apply_rope(k_raw.reshape(b_sz, s_len, A_HEADS, 2, A_QK_DIM), cos, sin)
    v = v_raw.reshape(b_sz, s_len, A_HEADS, A_V_DIM)
    nblk = s_len // Q_BLOCK
    qb = jnp.moveaxis(q.reshape(b_sz, nblk, Q_BLOCK, A_HEADS, 2, A_QK_DIM), 1, 0)
    key_pos = jnp.arange(s_len)
    scale = A_QK_DIM ** -0.5

    def block(args):
        qblk, bi = args
        s = jnp.einsum('bqhcd,bkhcd->bhcqk', qblk, k).astype(jnp.float32) * scale
        q_pos = bi * Q_BLOCK + jnp.arange(Q_BLOCK)
        causal = key_pos[None, :] <= q_pos[:, None]
        p = jax.nn.softmax(jnp.where(causal, s, -jnp.inf), axis=-1)
        a = p[:, :, 0] - lam * p[:, :, 1]
        return jnp.einsum('bhqk,bkhe->bqhe', a.astype(v.dtype), v)

    out = lax.map(block, (qb, jnp.arange(nblk)))
    out = jnp.moveaxis(out, 0, 1).reshape(b_sz, s_len, A_HEADS, A_V_DIM)
    out = rmsnorm(out, g_head.reshape(A_HEADS, A_V_DIM), HEAD_EPS) * (1.0 - lam_init)
    return out.reshape(b_sz, s_len, A_WIDTH)


def setup_inputs(seed: int = 0) -> dict:
    key = jax.random.key(seed)
    ks = jax.random.split(key, 20)
    nrm = lambda k, shape, s: jax.random.normal(k, shape, jnp.float32) * s
    b_i = nrm(ks[5], (DEPTH, M_HEADS), 0.1)
    b_f = 3.0 + 3.0 * jax.random.uniform(ks[6], (DEPTH, M_HEADS), jnp.float32)
    return {
        'x': nrm(ks[0], (BATCH, SEQ, D_MODEL), 1.0),
        'g_mix': 1.0 + nrm(ks[1], (DEPTH, D_MODEL), 0.02),
        'w_in': nrm(ks[2], (DEPTH, D_MODEL, IN_WIDTH), D_MODEL ** -0.5),
        'conv_w': nrm(ks[3], (DEPTH, CONV_K, 2 * M_WIDTH), CONV_K ** -0.5),
        'conv_b': nrm(ks[4], (DEPTH, 2 * M_WIDTH), 0.01),
        'b_gates': jnp.concatenate([b_i, b_f], axis=-1),
        'g_mlstm_head': 1.0 + nrm(ks[7], (DEPTH, M_WIDTH), 0.02),
        'lam_q1': nrm(ks[8], (DEPTH, A_QK_DIM), 0.1),
        'lam_k1': nrm(ks[9], (DEPTH, A_QK_DIM), 0.1),
        'lam_q2': nrm(ks[10], (DEPTH, A_QK_DIM), 0.1),
        'lam_k2': nrm(ks[11], (DEPTH, A_QK_DIM), 0.1),
        'g_diff_head': 1.0 + nrm(ks[12], (DEPTH, A_WIDTH), 0.02),
        'w_out': nrm(ks[13], (DEPTH, MIX_WIDTH, D_MODEL), MIX_WIDTH ** -0.5),
        'g_ffn': 1.0 + nrm(ks[14], (DEPTH, D_MODEL), 0.02),
        'w_gate': nrm(ks[15], (DEPTH, D_MODEL, FFN_HIDDEN), D_MODEL ** -0.5),
        'w_up': nrm(ks[16], (DEPTH, D_MODEL, FFN_HIDDEN), D_MODEL ** -0.5),
        'w_down': nrm(ks[17], (DEPTH, FFN_HIDDEN, D_MODEL), FFN_HIDDEN ** -0.5),
        'g_final': 1.0 + nrm(ks[18], (D_MODEL,), 0.02),
    }


def reference(x, g_mix, w_in, conv_w, conv_b, b_gates, g_mlstm_head, lam_q1, lam_k1,
              lam_q2, lam_k2, g_diff_head, w_out, g_ffn, w_gate, w_up, w_down, g_final):
    cos, sin = rope_tables(x.shape[1], A_QK_DIM)
    for l in range(DEPTH):
        h = rmsnorm(x, g_mix[l])
        z = h @ w_in[l]
        qk_m, v_m, o_m, gates, q_a, k_a, v_a = jnp.split(z, SPLITS, axis=-1)
        m_out = mlstm_mixer(qk_m, v_m, o_m, gates + b_gates[l], conv_w[l], conv_b[l],
                            g_mlstm_head[l])
        lam_init = 0.8 - 0.6 * math.exp(-0.3 * l)
        lam = (jnp.exp(jnp.sum(lam_q1[l].astype(jnp.float32) * lam_k1[l].astype(jnp.float32)))
               - jnp.exp(jnp.sum(lam_q2[l].astype(jnp.float32) * lam_k2[l].astype(jnp.float32)))
               + lam_init)
        a_out = diff_attention_mixer(q_a, k_a, v_a, cos, sin, lam, lam_init, g_diff_head[l])
        x = x + jnp.concatenate([m_out, a_out.astype(m_out.dtype)], axis=-1) @ w_out[l]
        h2 = rmsnorm(x, g_ffn[l])
        x = x + (jax.nn.silu(h2 @ w_gate[l]) * (h2 @ w_up[l])) @ w_down[l]
    return rmsnorm(x, g_final)
```

```cpp
#include <hip/hip_runtime.h>
#include <cstdio>
#include <cstdint>
#include <cmath>
namespace pg8 {
#define PG8_LAS __attribute__((address_space(3)))
typedef unsigned short bf16_t;
typedef short bf16x8 __attribute__((ext_vector_type(8)));
typedef float f32x4 __attribute__((ext_vector_type(4)));
typedef unsigned u32x4 __attribute__((ext_vector_type(4)));
constexpr int BM = 256, BK = 64, HALF = 128, HTB = HALF * BK * 2  , STAGE_BYTES = 8 * HTB, NXCD = 8, WGM = 8;

__host__ __device__ __forceinline__ int lds_byte(int r, int c) { const int st = (r >> 4) * 2 + (c >> 5), rr = r & 15, cc = c & 31, ob = rr * 64 + cc * 2; return st * 1024 + (ob ^ (((ob >> 9) & 1) << 5)); }
__host__ __device__ __forceinline__ void stage_rc(int b, int& R, int& C) { const int st = b / 1024, sb = b % 1024, swz = sb ^ (((sb >> 9) & 1) << 5); R = (st >> 1) * 16 + swz / 64; C = (st & 1) * 32 + (swz % 64) / 2; }
__host__ __device__ __forceinline__ int perm32(int rho) { const int n = rho >> 4, i = rho & 15; return 8 * (i >> 2) + 4 * n + (i & 3); }

struct Unit { int pm, pn; };
struct Gemm { const bf16_t* A; const bf16_t* Bt; int M, N, K; };

struct StaticOrder {
    int nM, nN, nwg, G, c;
    __host__ __device__ void init(int M, int N, int G_, int c_) { nM = M / BM; nN = N / BM; nwg = nM * nN; G = G_; c = c_; }
    __host__ __device__ bool next(int i, Unit& u) const {
        const long L = (long)i * G + c; if (L >= nwg) return false;
        int wgid = (int)L; { const int q = nwg / NXCD, r = nwg % NXCD, xcd = wgid % NXCD, off = wgid / NXCD; wgid = (xcd < r ? xcd * (q + 1) : r * (q + 1) + (xcd - r) * q) + off; }
        const int nig = WGM * nN, gid = wgid / nig, fm = gid * WGM, gsz = (nM - fm) < WGM ? (nM - fm) : WGM;
        u.pm = fm + ((wgid % nig) % gsz); u.pn = (wgid % nig) / gsz; return true;
    }
    __device__ __forceinline__ void a_ready(const Unit&) const {}
    __device__ __forceinline__ void done(const Unit&) const {}
};

__device__ __forceinline__ unsigned cvt_pk_bf16(float lo, float hi) { unsigned r; asm volatile("v_cvt_pk_bf16_f32 %0, %1, %2" : "=v"(r) : "v"(lo), "v"(hi)); return r; }
typedef float f32x2 __attribute__((ext_vector_type(2)));
constexpr int ROWSS_SLOTS = 16;
__device__ __forceinline__ float row_rstd(const float* rowss, int row, int fq, float eps) {
    const f32x4 q = *(const f32x4*)(rowss + (size_t)row * ROWSS_SLOTS + fq * 4);
    float s = (q[0] + q[1]) + (q[2] + q[3]);
    s += __shfl_xor(s, 16); s += __shfl_xor(s, 32);
    return __builtin_amdgcn_rsqf(s * (1.0f / 1024.0f) + eps);
}
struct EpiIn {
    static constexpr bool PERM = true, AFTER_DRAIN = false;
    bf16_t* Z; int ZP; const float* rowss; const float* cosT; const float* sinT; float eps; float qscale;
    __device__ __forceinline__ void operator()(const f32x4 (&acc)[2][2][4][2], const Unit& u, int wr, int wc, int fr, int fq) const {
        const int row0 = u.pm * BM + wr * 64 + fr;
        if (u.pn >= 8 && u.pn < 12) {
            const bool isq = u.pn < 10; const int tile = isq ? u.pn - 8 : u.pn - 10;
            const int head = 2 * tile + (wc >> 1), cm = wc & 1;
            const int colbase = (isq ? 2048 : 2560) + head * 128 + cm * 64 + 8 * fq;
            const float sc = isq ? qscale : 1.f;
#pragma unroll
            for (int ai = 0; ai < 2; ++ai)
#pragma unroll
                for (int m = 0; m < 4; ++m) {
                    const int row = row0 + ai * HALF + m * 16; const float rs = row_rstd(rowss, row, fq, eps) * sc; const int pos = row & 2047;
                    const f32x4 c0 = *(const f32x4*)(cosT + pos * 32 + 8 * fq), c1 = *(const f32x4*)(cosT + pos * 32 + 8 * fq + 4);
                    const f32x4 s0 = *(const f32x4*)(sinT + pos * 32 + 8 * fq), s1 = *(const f32x4*)(sinT + pos * 32 + 8 * fq + 4);
                    const f32x4 a0 = acc[ai][0][m][0] * rs, a1 = acc[ai][0][m][1] * rs, b0 = acc[ai][1][m][0] * rs, b1 = acc[ai][1][m][1] * rs;
                    const f32x4 o10 = a0 * c0 - b0 * s0, o11 = a1 * c1 - b1 * s1, o20 = b0 * c0 + a0 * s0, o21 = b1 * c1 + a1 * s1;
                    bf16_t* rowp = Z + (size_t)row * ZP + colbase;
                    u32x4 w; w.x = cvt_pk_bf16(o10[0], o10[1]); w.y = cvt_pk_bf16(o10[2], o10[3]); w.z = cvt_pk_bf16(o11[0], o11[1]); w.w = cvt_pk_bf16(o11[2], o11[3]);
                    *(u32x4*)rowp = w;
                    w.x = cvt_pk_bf16(o20[0], o20[1]); w.y = cvt_pk_bf16(o20[2], o20[3]); w.z = cvt_pk_bf16(o21[0], o21[1]); w.w = cvt_pk_bf16(o21[2], o21[3]);
                    *(u32x4*)(rowp + 32) = w;
                }
        } else {
            const int col0 = u.pn * BM + wc * 32 + 8 * fq;
#pragma unroll
            for (int ai = 0; ai < 2; ++ai)
#pragma unroll
                for (int m = 0; m < 4; ++m) {
                    const int row = row0 + ai * HALF + m * 16; const float rs = row_rstd(rowss, row, fq, eps);
                    bf16_t* rowp = Z + (size_t)row * ZP + col0;
#pragma unroll
                    for (int bj = 0; bj < 2; ++bj) { const f32x4 v0 = acc[ai][bj][m][0] * rs, v1 = acc[ai][bj][m][1] * rs;
                        u32x4 w; w.x = cvt_pk_bf16(v0[0], v0[1]); w.y = cvt_pk_bf16(v0[2], v0[3]); w.z = cvt_pk_bf16(v1[0], v1[1]); w.w = cvt_pk_bf16(v1[2], v1[3]);
                        *(u32x4*)(rowp + bj * HALF) = w; }
                }
        }
    }
};
struct EpiGU {
    static constexpr bool PERM = true, AFTER_DRAIN = false;
    bf16_t* H; int HP; const float* rowss; float eps;
    __device__ __forceinline__ void operator()(const f32x4 (&acc)[2][2][4][2], const Unit& u, int wr, int wc, int fr, int fq) const {
        const int row0 = u.pm * BM + wr * 64 + fr; const int col0 = u.pn * HALF + wc * 32 + 8 * fq;
#pragma unroll
        for (int ai = 0; ai < 2; ++ai)
#pragma unroll
            for (int m = 0; m < 4; ++m) {
                const int row = row0 + ai * HALF + m * 16; const float rs = row_rstd(rowss, row, fq, eps);
                f32x4 hv[2];
#pragma unroll
                for (int n = 0; n < 2; ++n) { const f32x4 g = acc[ai][0][m][n] * rs, up = acc[ai][1][m][n] * rs;
#pragma unroll
                    for (int j = 0; j < 4; ++j) hv[n][j] = g[j] * __builtin_amdgcn_rcpf(1.0f + __expf(-g[j])) * up[j]; }
                u32x4 w; w.x = cvt_pk_bf16(hv[0][0], hv[0][1]); w.y = cvt_pk_bf16(hv[0][2], hv[0][3]); w.z = cvt_pk_bf16(hv[1][0], hv[1][1]); w.w = cvt_pk_bf16(hv[1][2], hv[1][3]);
                *(u32x4*)(H + (size_t)row * HP + col0) = w;
            }
    }
};
struct EpiRes {
    static constexpr bool PERM = true, AFTER_DRAIN = false;
    const float* resid; float* xo; bf16_t* xb; float* rowss;
    __device__ __forceinline__ void operator()(const f32x4 (&acc)[2][2][4][2], const Unit& u, int wr, int wc, int fr, int fq) const {
        const int row0 = u.pm * BM + wr * 64 + fr; const int col0 = u.pn * BM + wc * 32 + 8 * fq;
#pragma unroll
        for (int ai = 0; ai < 2; ++ai)
#pragma unroll
            for (int m = 0; m < 4; ++m) {
                const int row = row0 + ai * HALF + m * 16; const size_t off = (size_t)row * 1024 + col0; float ss = 0.f;
#pragma unroll
                for (int bj = 0; bj < 2; ++bj) {
                    const f32x4 r0 = *(const f32x4*)(resid + off + bj * HALF), r1 = *(const f32x4*)(resid + off + bj * HALF + 4);
                    const f32x4 v0 = r0 + acc[ai][bj][m][0], v1 = r1 + acc[ai][bj][m][1];
                    *(f32x4*)(xo + off + bj * HALF) = v0; *(f32x4*)(xo + off + bj * HALF + 4) = v1;
                    u32x4 w; w.x = cvt_pk_bf16(v0[0], v0[1]); w.y = cvt_pk_bf16(v0[2], v0[3]); w.z = cvt_pk_bf16(v1[0], v1[1]); w.w = cvt_pk_bf16(v1[2], v1[3]);
                    *(u32x4*)(xb + off + bj * HALF) = w;
                    ss += (v0[0] * v0[0] + v0[1] * v0[1]) + (v0[2] * v0[2] + v0[3] * v0[3]) + (v1[0] * v1[0] + v1[1] * v1[1]) + (v1[2] * v1[2] + v1[3] * v1[3]);
                }
                ss += __shfl_xor(ss, 16); ss += __shfl_xor(ss, 32);
                if (fq == 0) rowss[(size_t)row * ROWSS_SLOTS + u.pn * 4 + wc] = ss;
                if (m & 1) asm volatile("" ::: "memory");
            }
    }
};

template <class Epi, class Sched, bool ALIGN_EPI = false, bool SP2 = false>
__device__ __forceinline__ void gemm_phase(PG8_LAS unsigned char* lds, const Gemm g, const Sched& S, const Epi& E) {
    int tid_ = threadIdx.x; asm volatile("" : "+v"(tid_));
    const int tid = tid_, wid = __builtin_amdgcn_readfirstlane(tid >> 6), lane = tid & 63, wr = wid >> 2, wc = wid & 3, fr = lane & 15, fq = lane >> 4;
    const int K = g.K, nt = K / BK;
    unsigned voffA[2], voffB[2];
#pragma unroll
    for (int i = 0; i < 2; ++i) { int R, C; stage_rc(tid * 16 + i * 8192, R, C); const int Rb = Epi::PERM ? ((R & ~31) + perm32(R & 31)) : R;
        voffA[i] = (unsigned)(R * K + C) * 2u; voffB[i] = (unsigned)(Rb * K + C) * 2u; }
    const size_t kstep = (size_t)(BK * 2);
    const size_t hstep = (size_t)HALF * K * 2;
    const size_t tstep = 2 * hstep;
    const unsigned ldsw = (unsigned)wid * 1024u;
    const int aoff = lds_byte(wr * 64 + fr, fq * 8), boff = lds_byte(wc * 32 + fr, fq * 8);
#define PG8_SA(b, h) (((b) * 2 + (h)) * HTB)
#define PG8_SB(b, h) ((4 + (b) * 2 + (h)) * HTB)
#define PG8_STAGE(bufoff, gbase, voff) do { _Pragma("unroll") for (int _i = 0; _i < 2; ++_i) \
        __builtin_amdgcn_global_load_lds((const unsigned*)((const char*)(gbase) + (voff)[_i]), (PG8_LAS unsigned*)(lds + (bufoff) + ldsw + _i * 8192), 16, 0, 0); } while (0)
#define PG8_LDA(dst, b, h) do { _Pragma("unroll") for (int m = 0; m < 4; ++m) _Pragma("unroll") for (int k = 0; k < 2; ++k) dst[m][k] = *(const PG8_LAS bf16x8*)(lds + PG8_SA(b, h) + aoff + m * 2048 + k * 1024); } while (0)
#define PG8_LDB(dst, b, h) do { _Pragma("unroll") for (int n = 0; n < 2; ++n) _Pragma("unroll") for (int k = 0; k < 2; ++k) dst[n][k] = *(const PG8_LAS bf16x8*)(lds + PG8_SB(b, h) + boff + n * 2048 + k * 1024); } while (0)
#define PG8_MMA(ai, bj, At, Bt) do { __builtin_amdgcn_s_setprio(1); _Pragma("unroll") for (int m = 0; m < 4; ++m) _Pragma("unroll") for (int n = 0; n < 2; ++n) _Pragma("unroll") for (int k = 0; k < 2; ++k) \
        acc[ai][bj][m][n] = __builtin_amdgcn_mfma_f32_16x16x32_bf16(Bt[n][k], At[m][k], acc[ai][bj][m][n], 0, 0, 0); __builtin_amdgcn_s_setprio(0); } while (0)
#define PG8_WAIT_V(n) asm volatile("s_waitcnt vmcnt(" #n ")" ::: "memory")
#define PG8_WAIT_L(n) asm volatile("s_waitcnt lgkmcnt(" #n ")" ::: "memory")
#define PG8_BAR __builtin_amdgcn_s_barrier()
#define PG8_SCHED __builtin_amdgcn_sched_barrier(0)
    Unit cur, nxt; int ui = 0;
    if (!S.next(0, cur)) return;
    f32x4 acc[2][2][4][2];
#pragma unroll
    for (int a = 0; a < 2; ++a)
#pragma unroll
        for (int b = 0; b < 2; ++b)
#pragma unroll
            for (int m = 0; m < 4; ++m)
#pragma unroll
                for (int n = 0; n < 2; ++n) acc[a][b][m][n] = (f32x4){0.f, 0.f, 0.f, 0.f};
    bf16x8 At[4][2], B0[2][2], B1[2][2];
    const char* cA = (const char*)g.A + (size_t)cur.pm * tstep; const char* cB = (const char*)g.Bt + (size_t)cur.pn * tstep;
    S.a_ready(cur);
    if constexpr (SP2) {
        PG8_STAGE(PG8_SB(0, 0), cB, voffB); PG8_STAGE(PG8_SB(0, 1), cB + hstep, voffB); PG8_STAGE(PG8_SA(0, 0), cA, voffA); PG8_STAGE(PG8_SA(0, 1), cA + hstep, voffA);
        if (wr == 1) PG8_BAR;
        PG8_WAIT_V(2); PG8_BAR;
        PG8_STAGE(PG8_SB(1, 0), cB + kstep, voffB); PG8_STAGE(PG8_SA(1, 0), cA + kstep, voffA); PG8_STAGE(PG8_SB(1, 1), cB + hstep + kstep, voffB);
        PG8_WAIT_V(6); PG8_BAR;
    } else {
        PG8_STAGE(PG8_SB(0, 0), cB, voffB); PG8_STAGE(PG8_SA(0, 0), cA, voffA); PG8_STAGE(PG8_SB(0, 1), cB + hstep, voffB); PG8_STAGE(PG8_SA(0, 1), cA + hstep, voffA);
        if (wr == 1) PG8_BAR;
        PG8_WAIT_V(4); PG8_BAR;
        PG8_STAGE(PG8_SB(1, 0), cB + kstep, voffB); PG8_STAGE(PG8_SA(1, 0), cA + kstep, voffA); PG8_STAGE(PG8_SB(1, 1), cB + hstep + kstep, voffB);
        PG8_WAIT_V(6); PG8_BAR;
    }
    for (;;) {
        const bool has_next = S.next(ui + 1, nxt);
        const char* nA = has_next ? (const char*)g.A + (size_t)nxt.pm * tstep : cA; const char* nB = has_next ? (const char*)g.Bt + (size_t)nxt.pn * tstep : cB;
        for (int t = 0; t < nt; t += 2) {
            const bool last = (t == nt - 2);
            const char* a1 = cA + (size_t)(t + 1) * kstep;
            const char* a2 = last ? nA : cA + (size_t)(t + 2) * kstep; const char* b2 = last ? nB : cB + (size_t)(t + 2) * kstep;
            const char* a3 = a2 + kstep; const char* b3 = b2 + kstep;
            if (last && has_next) S.a_ready(nxt);
            if constexpr (SP2) {
            PG8_LDB(B0, 0, 0); PG8_LDB(B1, 0, 1); PG8_SCHED; PG8_LDA(At, 0, 0); PG8_STAGE(PG8_SA(1, 1), a1 + hstep, voffA);
            PG8_WAIT_V(8); PG8_WAIT_L(0); PG8_BAR; PG8_MMA(0, 0, At, B0); PG8_MMA(0, 1, At, B1); PG8_BAR; PG8_SCHED;
            PG8_LDA(At, 0, 1); PG8_STAGE(PG8_SB(0, 0), b2, voffB); PG8_STAGE(PG8_SB(0, 1), b2 + hstep, voffB); PG8_STAGE(PG8_SA(0, 0), a2, voffA);
            PG8_WAIT_V(8); PG8_WAIT_L(0); PG8_BAR; PG8_MMA(1, 0, At, B0); PG8_MMA(1, 1, At, B1); PG8_BAR; PG8_SCHED;
            PG8_LDB(B0, 1, 0); PG8_LDB(B1, 1, 1); PG8_SCHED; PG8_LDA(At, 1, 0); PG8_STAGE(PG8_SA(0, 1), a2 + hstep, voffA);
            PG8_WAIT_V(8); PG8_WAIT_L(0); PG8_BAR; PG8_MMA(0, 0, At, B0); PG8_MMA(0, 1, At, B1); PG8_BAR; PG8_SCHED;
            PG8_LDA(At, 1, 1); PG8_STAGE(PG8_SB(1, 0), b3, voffB); PG8_STAGE(PG8_SB(1, 1), b3 + hstep, voffB); PG8_STAGE(PG8_SA(1, 0), a3, voffA);
            PG8_WAIT_V(8); PG8_WAIT_L(0); PG8_BAR; PG8_MMA(1, 0, At, B0); PG8_MMA(1, 1, At, B1); PG8_BAR; PG8_SCHED;
            } else {
            PG8_LDB(B0, 0, 0); PG8_SCHED; PG8_LDA(At, 0, 0); PG8_STAGE(PG8_SA(1, 1), a1 + hstep, voffA);
            PG8_WAIT_L(8); PG8_BAR; PG8_WAIT_L(0); PG8_MMA(0, 0, At, B0); PG8_BAR; PG8_SCHED;
            PG8_LDB(B1, 0, 1); PG8_STAGE(PG8_SB(0, 0), b2, voffB);
            PG8_BAR; PG8_WAIT_L(0); PG8_MMA(0, 1, At, B1); PG8_BAR;
            PG8_LDA(At, 0, 1); PG8_STAGE(PG8_SA(0, 0), a2, voffA);
            PG8_BAR; PG8_WAIT_L(0); PG8_MMA(1, 0, At, B0); PG8_BAR; PG8_SCHED;
            PG8_STAGE(PG8_SB(0, 1), b2 + hstep, voffB);
            PG8_WAIT_V(6); PG8_BAR; PG8_MMA(1, 1, At, B1); PG8_BAR;
            PG8_LDB(B0, 1, 0); PG8_SCHED; PG8_LDA(At, 1, 0); PG8_STAGE(PG8_SA(0, 1), a2 + hstep, voffA);
            PG8_WAIT_L(8); PG8_BAR; PG8_WAIT_L(0); PG8_MMA(0, 0, At, B0); PG8_BAR; PG8_SCHED;
            PG8_LDB(B1, 1, 1); PG8_STAGE(PG8_SB(1, 0), b3, voffB);
            PG8_BAR; PG8_WAIT_L(0); PG8_MMA(0, 1, At, B1); PG8_BAR;
            PG8_LDA(At, 1, 1); PG8_STAGE(PG8_SA(1, 0), a3, voffA);
            PG8_BAR; PG8_WAIT_L(0); PG8_MMA(1, 0, At, B0); PG8_BAR; PG8_SCHED;
            PG8_STAGE(PG8_SB(1, 1), b3 + hstep, voffB);
            PG8_WAIT_V(6); PG8_BAR; PG8_MMA(1, 1, At, B1); PG8_BAR;
            }
        }
        if constexpr (ALIGN_EPI) { if (wr == 0) PG8_BAR; }
        if constexpr (!Epi::AFTER_DRAIN) { E(acc, cur, wr, wc, fr, fq); S.done(cur); }
        if (!has_next) break;
#pragma unroll
        for (int a = 0; a < 2; ++a)
#pragma unroll
            for (int b = 0; b < 2; ++b)
#pragma unroll
                for (int m = 0; m < 4; ++m)
#pragma unroll
                    for (int n = 0; n < 2; ++n) acc[a][b][m][n] = (f32x4){0.f, 0.f, 0.f, 0.f};
        cur = nxt; cA = nA; cB = nB; ++ui;
        if constexpr (ALIGN_EPI) { if (wr == 1) PG8_BAR; }
    }
    PG8_WAIT_V(0);
    if constexpr (!ALIGN_EPI) { if (wr == 0) PG8_BAR; }
    PG8_BAR;
    if constexpr (Epi::AFTER_DRAIN) { E.fused(acc, cur, wr, wc, fr, fq, lds, wid, lane); S.done(cur); }
#undef PG8_SA
#undef PG8_SB
#undef PG8_STAGE
#undef PG8_LDA
#undef PG8_LDB
#undef PG8_MMA
#undef PG8_WAIT_V
#undef PG8_WAIT_L
#undef PG8_BAR
#undef PG8_SCHED
}
}
#define GAS __attribute__((address_space(1)))
#define LAS __attribute__((address_space(3)))
typedef unsigned short bf16;
typedef unsigned v4u __attribute__((ext_vector_type(4)));
typedef float f32x4 __attribute__((ext_vector_type(4)));
typedef short bf16x8 __attribute__((ext_vector_type(8)));
typedef GAS unsigned gu32;
typedef GAS unsigned long long gu64;
#define RLX_AGENT __ATOMIC_RELAXED, __HIP_MEMORY_SCOPE_AGENT
#define LDS_WAIT() asm volatile("s_waitcnt lgkmcnt(0)" ::: "memory")
#define VM_WAIT() asm volatile("s_waitcnt vmcnt(0)" ::: "memory")
__device__ __forceinline__ unsigned long long rt() { return __builtin_amdgcn_s_memrealtime(); }
__device__ __forceinline__ unsigned f2bf(float f) { unsigned u = __builtin_bit_cast(unsigned, f); return (u + 0x7fffu + ((u >> 16) & 1u)) >> 16; }
__device__ __forceinline__ unsigned pk2(float lo, float hi) { return f2bf(lo) | (f2bf(hi) << 16); }

#define XB_TMO      128
#define XB_XCNT(j)  (256  + 64 * (j))
#define XB_XSUB(j)  (1280 + 64 * (j))
#define XB_XGEN(j)  (2304 + 64 * (j))
#define XB_TOP      3328
#define XB_TOPGEN   3392
#define XCD_BAR_WORDS 3456
#define XB_SPIN_CAP (1u << 18)

__device__ __forceinline__ unsigned xb_ld(unsigned* p)              { return __hip_atomic_load(p, __ATOMIC_RELAXED, __HIP_MEMORY_SCOPE_AGENT); }
__device__ __forceinline__ unsigned xb_add(unsigned* p, unsigned v) { return __hip_atomic_fetch_add(p, v, __ATOMIC_RELAXED, __HIP_MEMORY_SCOPE_AGENT); }
__device__ __forceinline__ unsigned xb_xcc_id() { return (unsigned)__builtin_amdgcn_s_getreg((3 << 11) | 20) & 0xFu; }
#define XB_SPIN(cond, bar) do { unsigned _sp = 0; while (cond) { __builtin_amdgcn_s_sleep(1); \
    if ((++_sp & 255u) == 0u) { if (xb_ld(&(bar)[XB_TMO])) break; if (_sp > XB_SPIN_CAP) { atomicAdd(&(bar)[XB_TMO], 1u); break; } } } } while (0)

struct XcdBarrier {
    unsigned* bar; unsigned x;
    volatile LAS unsigned* st;
};

__device__ __forceinline__ XcdBarrier xcd_barrier_post(unsigned* bar, volatile LAS unsigned* st) {
    XcdBarrier b; b.bar = bar; b.x = xb_xcc_id(); b.st = st;
    if (threadIdx.x == 0) (void)xb_add(&bar[XB_XCNT(b.x)], 1u);
    return b;
}
__device__ __forceinline__ void xcd_barrier_complete(unsigned* bar, unsigned x, unsigned& nloc, unsigned& nx) {
    const unsigned G = gridDim.x * gridDim.y * gridDim.z;
    unsigned sum, cnt, mine, sp = 0u;
    for (;;) {
        sum = 0u; cnt = 0u; mine = 0u;
#pragma unroll
        for (unsigned j = 0; j < 16; ++j) { const unsigned c = xb_ld(&bar[XB_XCNT(j)]); sum += c; cnt += (c > 0u) ? 1u : 0u; mine = (j == x) ? c : mine; }
        if (sum == G) break;
        __builtin_amdgcn_s_sleep(1);
        if ((++sp & 255u) == 0u) { if (xb_ld(&bar[XB_TMO])) break; if (sp > XB_SPIN_CAP) { atomicAdd(&bar[XB_TMO], 1u); break; } }
    }
    nloc = mine > 0u ? mine : 1u; nx = cnt > 0u ? cnt : 1u;
}

__device__ __forceinline__ void xcd_barrier(const XcdBarrier& b) {
    asm volatile("s_waitcnt vmcnt(0)" ::: "memory");
    __syncthreads();
    if (threadIdx.x == 0) {
        unsigned* bar = b.bar;
        __builtin_amdgcn_s_waitcnt(0);
        unsigned nloc = b.st[0], nx = b.st[1];
        if (nloc == 0u) { xcd_barrier_complete(bar, b.x, nloc, nx); b.st[0] = nloc; b.st[1] = nx; }
        const unsigned old = xb_add(&bar[XB_XSUB(b.x)], 1u);
        const unsigned gen = old / nloc;
        if (old + 1u == (gen + 1u) * nloc) {
            __builtin_amdgcn_fence(__ATOMIC_RELEASE, "agent");
            asm volatile("s_waitcnt vmcnt(0)" ::: "memory");
            const unsigned og = xb_add(&bar[XB_TOP], 1u);
            const unsigned tg = og / nx;
            if (og + 1u == (tg + 1u) * nx) xb_add(&bar[XB_TOPGEN], 1u);
            else XB_SPIN(xb_ld(&bar[XB_TOPGEN]) == tg, bar);
            __builtin_amdgcn_fence(__ATOMIC_ACQUIRE, "agent");
            xb_add(&bar[XB_XGEN(b.x)], 1u);
            asm volatile("s_waitcnt vmcnt(0)" ::: "memory");
        } else {
            XB_SPIN(xb_ld(&bar[XB_XGEN(b.x)]) == gen, bar);
            __builtin_amdgcn_fence(__ATOMIC_ACQUIRE, "agent");
            asm volatile("s_waitcnt vmcnt(0)" ::: "memory");
        }
    }
    __syncthreads();
}

constexpr int NL = 4, BATCH = 16, SEQ = 2048, DM = 1024, M = BATCH * SEQ, FF = 2816, NIN = 3592;
constexpr int ZP = 3584;
constexpr int ZQM = 0, ZKM = 512, ZVM = 1024, ZOM = 1536, ZQA = 2048, ZKA = 2560, ZVA = 3072;
constexpr int NGU = 2 * FF;
constexpr float EPS = 1e-6f, HEAD_EPS = 1e-5f;
constexpr float C2 = 0.125f * 1.4426950408889634f;
constexpr int NWAVES = 8;
#ifndef MK_ONE_LAUNCH
#define MK_ONE_LAUNCH 0
#endif
constexpr int N_PHASES = 2 + 5 * NL;

constexpr size_t MiB = 1u << 20;
constexpr size_t WS_CTL = 0, CTL_ZERO_BYTES = 1 * MiB;
constexpr size_t WIN_L = (size_t)ZP * DM * 2, WOUT_L = (size_t)DM * DM * 2, WGU_L = (size_t)NGU * DM * 2, WDN_L = (size_t)DM * FF * 2;
constexpr size_t WS_WIN = 2 * MiB, WS_WOUT = WS_WIN + NL * WIN_L, WS_WGU = WS_WOUT + NL * WOUT_L, WS_WDN = WS_WGU + NL * WGU_L;
constexpr size_t WS_WG = WS_WDN + NL * WDN_L;
constexpr size_t WS_COS = WS_WG + (size_t)NL * 8 * DM * 4, WS_SIN = WS_COS + (size_t)SEQ * 32 * 4;
constexpr size_t WS_ROWSS = 106 * MiB;
constexpr size_t WS_GATES = 108 * MiB;
constexpr size_t WS_XB = 110 * MiB;
constexpr size_t WS_MIX = 174 * MiB;
constexpr size_t WS_Z = 238 * MiB;
constexpr size_t WS_END = WS_Z + (size_t)M * ZP * 2;
static_assert(WS_SIN + (size_t)SEQ * 32 * 4 <= WS_ROWSS && WS_END <= 512 * MiB, "d_ws map");
constexpr int CW_TMO = 0, CW_CODE = 1, CW_BAR = 4096;

constexpr int RING_OFF = 0, RING_BYTES = 131072;
constexpr int LDSCTL_OFF = RING_BYTES, MISC_OFF = LDSCTL_OFF + 320;
constexpr int LDS_BYTES = 147456;

typedef float f32x4g __attribute__((ext_vector_type(4)));
__device__ __forceinline__ float bf2f(unsigned short b) { return __uint_as_float((unsigned)b << 16); }
__device__ __forceinline__ void unpack8(const v4u& w, float* f) {
    f[0] = __uint_as_float(w.x << 16); f[1] = __uint_as_float(w.x & 0xffff0000u); f[2] = __uint_as_float(w.y << 16); f[3] = __uint_as_float(w.y & 0xffff0000u);
    f[4] = __uint_as_float(w.z << 16); f[5] = __uint_as_float(w.z & 0xffff0000u); f[6] = __uint_as_float(w.w << 16); f[7] = __uint_as_float(w.w & 0xffff0000u);
}
__device__ __forceinline__ v4u pack8(const float* f) {
    v4u w; w.x = pg8::cvt_pk_bf16(f[0], f[1]); w.y = pg8::cvt_pk_bf16(f[2], f[3]); w.z = pg8::cvt_pk_bf16(f[4], f[5]); w.w = pg8::cvt_pk_bf16(f[6], f[7]); return w;
}

struct Frame {
    LAS unsigned char* lds;
    volatile LAS unsigned* MISC;
    gu32* ctl;
    int tid, lane, wave;
    int vcu, G;
    const float *x, *g_mix, *w_in, *conv_w, *conv_b, *b_gates, *g_mh, *lq1, *lk1, *lq2, *lk2, *g_dh, *w_out, *g_ffn, *w_gate, *w_up, *w_down, *g_final;
    float* out;
    bf16 *Win, *Wout, *Wgu, *Wdn, *XB, *MIX, *Z;
    float *Wg, *cosT, *sinT, *rowss, *gates;
};

__device__ __forceinline__ float wave_sum(float v) {
#pragma unroll
    for (int o = 1; o < 64; o <<= 1) v += __shfl_xor(v, o);
    return v;
}

__device__ __forceinline__ void p0_item(const float* W, int ldw, int src_col0, const float* gk, bf16* WT, int K, int dst_row0, LAS float* scr, int k0, int lane) {
#pragma unroll 8
    for (int i = 0; i < 32; ++i) { const int kk = 2 * i + (lane >> 5); float v = W[(size_t)(k0 + kk) * ldw + src_col0 + (lane & 31)]; if (gk) v *= gk[k0 + kk]; scr[kk * 33 + (lane & 31)] = v; }
    LDS_WAIT(); asm volatile("" ::: "memory");
    const int c = lane & 7;
#pragma unroll
    for (int j = 0; j < 4; ++j) { const int n = (lane >> 3) + 8 * j; const LAS float* s = scr + (8 * c) * 33 + n;
        v4u o; o.x = pg8::cvt_pk_bf16(s[0 * 33], s[1 * 33]); o.y = pg8::cvt_pk_bf16(s[2 * 33], s[3 * 33]); o.z = pg8::cvt_pk_bf16(s[4 * 33], s[5 * 33]); o.w = pg8::cvt_pk_bf16(s[6 * 33], s[7 * 33]);
        *(GAS v4u*)(WT + (size_t)(dst_row0 + n) * K + k0 + 8 * c) = o; }
    LDS_WAIT(); asm volatile("" ::: "memory");
}
__constant__ double ROPE_INV[32] = {1.0, 0.7498942093324559, 0.5623413251903491, 0.4216965034285822, 0.31622776601683794, 0.23713737056616552, 0.1778279410038923, 0.1333521432163324,
    0.1, 0.07498942093324558, 0.05623413251903491, 0.042169650342858224, 0.03162277660168379, 0.023713737056616554, 0.01778279410038923, 0.01333521432163324,
    0.01, 0.007498942093324558, 0.005623413251903491, 0.004216965034285823, 0.0031622776601683794, 0.0023713737056616554, 0.0017782794100389228, 0.001333521432163324,
    0.001, 0.0007498942093324559, 0.0005623413251903491, 0.00042169650342858224, 0.00031622776601683794, 0.00023713737056616554, 0.00017782794100389227, 0.0001333521432163324};
__device__ __forceinline__ void sincos_d(double a, double& s, double& c) {
    const double k = __builtin_rint(a * 0.6366197723675814);
    double r = __builtin_fma(-k, 1.5707963267948966, a); r = __builtin_fma(-k, 6.123233995736766e-17, r);
    const double r2 = r * r;
    double sp = -7.647163731819816e-13; sp = sp * r2 + 1.6059043836821613e-10; sp = sp * r2 - 2.505210838544172e-08; sp = sp * r2 + 2.7557319223985893e-06; sp = sp * r2 - 0.0001984126984126984; sp = sp * r2 + 0.008333333333333333; sp = sp * r2 - 0.16666666666666666;
    const double sn = r + r * r2 * sp;
    double cp = 4.779477332387385e-14; cp = cp * r2 - 1.1470745597729725e-11; cp = cp * r2 + 2.08767569878681e-09; cp = cp * r2 - 2.755731922398589e-07; cp = cp * r2 + 2.48015873015873e-05; cp = cp * r2 - 0.001388888888888889; cp = cp * r2 + 0.041666666666666664; cp = cp * r2 - 0.5;
    const double cs = 1.0 + r2 * cp;
    const int q = (int)((long long)k & 3);
    s = (q == 0) ? sn : (q == 1) ? cs : (q == 2) ? -sn : -cs;
    c = (q == 0) ? cs : (q == 1) ? -sn : (q == 2) ? -cs : sn;
}
__device__ __forceinline__ void p0_prologue(Frame& F) {
    LAS float* scr = (LAS float*)(F.lds + RING_OFF + F.wave * 16384);
    const int gw = F.vcu * NWAVES + F.wave, NGW = F.G * NWAVES;
    constexpr int I_IN = 16 * 112, I_OUT = 16 * 32, I_GU = 16 * 176, I_DN = 44 * 32, I_L = I_IN + I_OUT + I_GU + I_DN;
    for (int it = gw; it < NL * I_L; it += NGW) {
        const int l = it / I_L; int r = it % I_L;
        if (r < I_IN) { const int kb = r / 112, G = r % 112; int src;
            if (G < 64) src = 32 * G;
            else if (G < 96) { const int rr = (G - 64) & 15, tile = rr >> 3, bj = (rr >> 2) & 1, grp = rr & 3; src = (G < 80 ? 2056 : 2568) + (2 * tile + (grp >> 1)) * 128 + (grp & 1) * 64 + bj * 32; }
            else src = 3080 + 32 * (G - 96);
            p0_item(F.w_in + (size_t)l * DM * NIN, NIN, src, F.g_mix + l * DM, F.Win + (size_t)l * ZP * DM, DM, 32 * G, scr, 64 * kb, F.lane); continue; }
        r -= I_IN;
        if (r < I_OUT) { const int kb = r / 32, G = r % 32; p0_item(F.w_out + (size_t)l * DM * DM, DM, 32 * G, nullptr, F.Wout + (size_t)l * DM * DM, DM, 32 * G, scr, 64 * kb, F.lane); continue; }
        r -= I_OUT;
        if (r < I_GU) { const int kb = r / 176, G = r % 176, tile = G >> 3, q = G & 7;
            const float* W = (q < 4 ? F.w_gate : F.w_up) + (size_t)l * DM * FF;
            p0_item(W, FF, 128 * tile + 32 * (q & 3), F.g_ffn + l * DM, F.Wgu + (size_t)l * NGU * DM, DM, 32 * G, scr, 64 * kb, F.lane); continue; }
        r -= I_GU;
        { const int kb = r / 32, G = r % 32; p0_item(F.w_down + (size_t)l * FF * DM, DM, 32 * G, nullptr, F.Wdn + (size_t)l * DM * FF, FF, 32 * G, scr, 64 * kb, F.lane); }
    }
    const int gt = (F.vcu * NWAVES + F.wave) * 64 + F.lane, NGT = F.G * NWAVES * 64;
    for (int i = gt; i < NL * 8 * DM; i += NGT) { const int l = i / (8 * DM), j = (i / DM) & 7, k = i % DM; F.Wg[i] = F.w_in[((size_t)l * DM + k) * NIN + 2048 + j] * F.g_mix[l * DM + k]; }
    for (int i = gt; i < SEQ * 32; i += NGT) { const int pos = i >> 5, fi = i & 31; double s, c; sincos_d((double)pos * ROPE_INV[fi], s, c); F.cosT[i] = (float)c; F.sinT[i] = (float)s; }
    for (int m = gw; m < M; m += NGW) {
        const GAS f32x4* xr = (const GAS f32x4*)(F.x + (size_t)m * DM) + F.lane;
        f32x4 v[4]; float s = 0.f;
#pragma unroll
        for (int j = 0; j < 4; ++j) { v[j] = xr[64 * j]; s += (v[j].x * v[j].x + v[j].y * v[j].y) + (v[j].z * v[j].z + v[j].w * v[j].w); }
        s = wave_sum(s);
        GAS unsigned long long* o8 = (GAS unsigned long long*)(F.XB + (size_t)m * DM) + F.lane;
#pragma unroll
        for (int j = 0; j < 4; ++j) o8[64 * j] = (unsigned long long)pg8::cvt_pk_bf16(v[j].x, v[j].y) | ((unsigned long long)pg8::cvt_pk_bf16(v[j].z, v[j].w) << 32);
        if (F.lane < 16) F.rowss[(size_t)m * 16 + F.lane] = (F.lane == 0) ? s : 0.f;
    }
}

__device__ __forceinline__ void gates_phase(Frame& F, int l) {
    const int gw = F.vcu * NWAVES + F.wave; const int lane = F.lane;
    float wg[8][16];
#pragma unroll
    for (int j = 0; j < 8; ++j)
#pragma unroll
        for (int i = 0; i < 2; ++i) { const float* p = F.Wg + ((size_t)l * 8 + j) * DM + 512 * i + 8 * lane; const f32x4 a = *(const f32x4*)p, b = *(const f32x4*)(p + 4);
            wg[j][8 * i + 0] = a.x; wg[j][8 * i + 1] = a.y; wg[j][8 * i + 2] = a.z; wg[j][8 * i + 3] = a.w; wg[j][8 * i + 4] = b.x; wg[j][8 * i + 5] = b.y; wg[j][8 * i + 6] = b.z; wg[j][8 * i + 7] = b.w; }
    const int rows_per_wave = M / (F.G * NWAVES);
    for (int rr = 0; rr < rows_per_wave; ++rr) {
        const int row = gw * rows_per_wave + rr;
        float xv[16];
        { const v4u a = *(const GAS v4u*)(F.XB + (size_t)row * DM + 8 * lane), b = *(const GAS v4u*)(F.XB + (size_t)row * DM + 512 + 8 * lane); unpack8(a, xv); unpack8(b, xv + 8); }
        float acc[8];
#pragma unroll
        for (int j = 0; j < 8; ++j) { float s = 0.f;
#pragma unroll
            for (int k = 0; k < 16; ++k) s += xv[k] * wg[j][k];
            acc[j] = wave_sum(s); }
        float ss = 0.f; if (lane < 16) ss = F.rowss[(size_t)row * 16 + lane]; ss = wave_sum(ss);
        const float rs = __builtin_amdgcn_rsqf(ss * (1.0f / 1024.0f) + EPS);
        if (lane == 0) { GAS f32x4* o = (GAS f32x4*)(F.gates + (size_t)row * 8); o[0] = (f32x4){acc[0] * rs, acc[1] * rs, acc[2] * rs, acc[3] * rs}; o[1] = (f32x4){acc[4] * rs, acc[5] * rs, acc[6] * rs, acc[7] * rs}; }
    }
}

struct Args { const float* in[18]; float* out; unsigned char* ws; int ph_lo, ph_hi; };
__device__ __forceinline__ void frame_init(Frame& F, const Args& args, unsigned char* lds) {
    F.lds = (LAS unsigned char*)lds;
    F.MISC = (volatile LAS unsigned*)(F.lds + MISC_OFF);
    F.tid = threadIdx.x; F.lane = F.tid & 63; F.wave = __builtin_amdgcn_readfirstlane(F.tid >> 6);
    F.G = gridDim.x; { const int bx = blockIdx.x; F.vcu = (F.G % 8 == 0) ? (bx % 8) * (F.G / 8) + bx / 8 : bx; }
    unsigned char* ws = args.ws;
    F.ctl = (gu32*)(ws + WS_CTL);
    F.x = args.in[0]; F.g_mix = args.in[1]; F.w_in = args.in[2]; F.conv_w = args.in[3]; F.conv_b = args.in[4]; F.b_gates = args.in[5]; F.g_mh = args.in[6];
    F.lq1 = args.in[7]; F.lk1 = args.in[8]; F.lq2 = args.in[9]; F.lk2 = args.in[10]; F.g_dh = args.in[11]; F.w_out = args.in[12]; F.g_ffn = args.in[13];
    F.w_gate = args.in[14]; F.w_up = args.in[15]; F.w_down = args.in[16]; F.g_final = args.in[17]; F.out = args.out;
    F.Win = (bf16*)(ws + WS_WIN); F.Wout = (bf16*)(ws + WS_WOUT); F.Wgu = (bf16*)(ws + WS_WGU); F.Wdn = (bf16*)(ws + WS_WDN);
    F.XB = (bf16*)(ws + WS_XB); F.MIX = (bf16*)(ws + WS_MIX); F.Z = (bf16*)(ws + WS_Z);
    F.Wg = (float*)(ws + WS_WG); F.cosT = (float*)(ws + WS_COS); F.sinT = (float*)(ws + WS_SIN); F.rowss = (float*)(ws + WS_ROWSS); F.gates = (float*)(ws + WS_GATES);
}

__device__ __forceinline__ float layer_lambda(Frame& F, int l, float lam_init) {
    float a = 0.f, b = 0.f;
    for (int i = 0; i < 64; ++i) { a += F.lq1[l * 64 + i] * F.lk1[l * 64 + i]; b += F.lq2[l * 64 + i] * F.lk2[l * 64 + i]; }
    return __expf(a) - __expf(b) + lam_init;
}
__device__ __forceinline__ void attn_naive_unit(Frame& F, int l, int b, int h, int qb, float lam, float lam_init) {
    const int tid = F.tid; const int vh = tid >> 8, c = (tid >> 7) & 1, r = tid & 127;
    const int qpos = qb * 128 + r; const size_t row = (size_t)b * SEQ + qpos;
    LAS float* Ks = (LAS float*)(F.lds + RING_OFF); LAS float* Vs = Ks + 4096; LAS float* XCH = Vs + 4096; LAS float* SSQ = XCH + 16384;
    float q[64];
#pragma unroll
    for (int i = 0; i < 8; ++i) { const v4u w = *(const GAS v4u*)(F.Z + row * ZP + ZQA + h * 128 + c * 64 + 8 * i); unpack8(w, q + 8 * i); }
    float o[64];
#pragma unroll
    for (int e = 0; e < 64; ++e) o[e] = 0.f;
    float mrun = -INFINITY, lsum = 0.f;
    const int nk = qb * 128 + 128;
    for (int j0 = 0; j0 < nk; j0 += 32) {
        __syncthreads();
        { const int cc = tid >> 8, key = (tid >> 3) & 31, d8 = (tid & 7) * 8; float f[8];
          const v4u w = *(const GAS v4u*)(F.Z + ((size_t)b * SEQ + j0 + key) * ZP + ZKA + h * 128 + cc * 64 + d8); unpack8(w, f);
#pragma unroll
          for (int i = 0; i < 8; ++i) Ks[cc * 2048 + key * 64 + d8 + i] = f[i]; }
        { const int key = tid >> 4, e8 = (tid & 15) * 8; float f[8];
          const v4u w = *(const GAS v4u*)(F.Z + ((size_t)b * SEQ + j0 + key) * ZP + ZVA + h * 128 + e8); unpack8(w, f);
#pragma unroll
          for (int i = 0; i < 8; ++i) Vs[key * 128 + e8 + i] = f[i]; }
        __syncthreads();
#pragma unroll 1
        for (int key = 0; key < 32; ++key) {
            const LAS f32x4* kp = (const LAS f32x4*)(Ks + c * 2048 + key * 64); float d0 = 0.f, d1 = 0.f;
#pragma unroll
            for (int d = 0; d < 16; d += 2) { const f32x4 k0 = kp[d], k1 = kp[d + 1];
                d0 += q[4 * d] * k0.x + q[4 * d + 1] * k0.y + q[4 * d + 2] * k0.z + q[4 * d + 3] * k0.w;
                d1 += q[4 * d + 4] * k1.x + q[4 * d + 5] * k1.y + q[4 * d + 6] * k1.z + q[4 * d + 7] * k1.w; }
            const float sv = (j0 + key <= qpos) ? (d0 + d1) : -INFINITY;
            if (sv > mrun) { const float alpha = exp2f(mrun - sv); lsum *= alpha;
#pragma unroll
                for (int e = 0; e < 64; ++e) o[e] *= alpha;
                mrun = sv; }
            const float p = exp2f(sv - mrun); lsum += p; const LAS f32x4* vp = (const LAS f32x4*)(Vs + key * 128 + vh * 64);
#pragma unroll
            for (int e = 0; e < 16; ++e) { const f32x4 v = vp[e]; o[4 * e] += p * v.x; o[4 * e + 1] += p * v.y; o[4 * e + 2] += p * v.z; o[4 * e + 3] += p * v.w; }
        }
    }
    const float inv = 1.0f / lsum;
#pragma unroll
    for (int e = 0; e < 64; ++e) o[e] *= inv;
    __syncthreads();
    if (c == 1) {
#pragma unroll
        for (int e = 0; e < 64; ++e) XCH[(vh * 128 + r) * 64 + e] = o[e]; }
    __syncthreads();
    float ss = 0.f;
    if (c == 0) {
#pragma unroll
        for (int e = 0; e < 64; ++e) { o[e] = o[e] - lam * XCH[(vh * 128 + r) * 64 + e]; ss += o[e] * o[e]; }
        SSQ[vh * 128 + r] = ss; }
    __syncthreads();
    if (c == 0) {
        const float rs = rsqrtf((SSQ[r] + SSQ[128 + r]) * (1.0f / 128.0f) + HEAD_EPS) * (1.0f - lam_init);
        const float* g = F.g_dh + l * 512 + h * 128 + vh * 64;
#pragma unroll
        for (int i = 0; i < 8; ++i) { float f[8];
#pragma unroll
            for (int j = 0; j < 8; ++j) f[j] = o[8 * i + j] * rs * g[8 * i + j];
            *(GAS v4u*)(F.MIX + row * DM + 512 + h * 128 + vh * 64 + 8 * i) = pack8(f); }
    }
    __syncthreads();
}

constexpr int MLP = 132;
__device__ __forceinline__ void mlstm_naive_unit(Frame& F, int l, int b, int h) {
    const int tid = F.tid, lane = F.lane, wave = F.wave;
    LAS float* Qs = (LAS float*)(F.lds + RING_OFF); LAS float* Ks = Qs + 64 * MLP; LAS float* Vs = Ks + 64 * MLP; LAS float* Ss = Vs + 64 * MLP;
    LAS float* sc_ii = Ss + 64 * 65; LAS float* sc_bc = sc_ii + 64; LAS float* sc_mt = sc_bc + 64; LAS float* sc_wi = sc_mt + 64; LAS float* sc_ws = sc_wi + 64; LAS float* sc_rd = sc_ws + 64;
    LAS float* nvec = sc_rd + 64; LAS float* sc_misc = nvec + 128;
    LAS float* HI = sc_misc + 16;
    LAS float* Hs = Qs;
    const int e = tid >> 2, dq = tid & 3;
    float C[32];
#pragma unroll
    for (int i = 0; i < 32; ++i) C[i] = 0.f;
    if (tid < 128) nvec[tid] = 0.f;
    if (tid == 0) { sc_misc[0] = 0.f; sc_misc[1] = 0.f; }
    const float bi = F.b_gates[l * 8 + h], bfg = F.b_gates[l * 8 + 4 + h];
    const float* cw = F.conv_w + (size_t)l * 4 * 1024; const float* cb = F.conv_b + (size_t)l * 1024;
    const float kscale = 0.08838834764831845f;
    __syncthreads();
    for (int ch = 0; ch < 32; ++ch) {
        const int t0 = ch * 64; const size_t rowb = (size_t)b * SEQ + t0;
#pragma unroll 1
        for (int idx = tid; idx < 64 * 128; idx += 512) { const int t = idx >> 7, d = idx & 127;
            float aq = cb[h * 128 + d], ak = cb[512 + h * 128 + d];
#pragma unroll
            for (int j = 0; j < 4; ++j) { const int tt = t0 + t - 3 + j; if (tt >= 0) { const bf16* zr = F.Z + ((size_t)b * SEQ + tt) * ZP;
                aq += bf2f(zr[ZQM + h * 128 + d]) * cw[j * 1024 + h * 128 + d]; ak += bf2f(zr[ZKM + h * 128 + d]) * cw[j * 1024 + 512 + h * 128 + d]; } }
            Qs[t * MLP + d] = aq / (1.0f + __expf(-aq)); Ks[t * MLP + d] = ak / (1.0f + __expf(-ak)) * kscale;
            Vs[t * MLP + d] = bf2f(F.Z[(rowb + t) * ZP + ZVM + h * 128 + d]); }
        if (tid < 64) { const float ip = F.gates[(rowb + tid) * 8 + h] + bi, fp = F.gates[(rowb + tid) * 8 + 4 + h] + bfg;
            sc_ii[tid] = ip; sc_bc[tid] = fminf(fp, 0.f) - log1pf(__expf(-fabsf(fp))); }
        __syncthreads();
        if (tid == 0) { const float mst = sc_misc[0]; float cum = 0.f, amax = -INFINITY;
#pragma unroll 1
            for (int t = 0; t < 64; ++t) { cum += sc_bc[t]; sc_bc[t] = cum; amax = fmaxf(amax, sc_ii[t] - cum); const float inter = cum + mst; const float mt = fmaxf(inter, cum + amax);
                sc_mt[t] = mt; sc_wi[t] = __expf(inter - mt); }
            const float blast = cum; float gmax = -INFINITY;
#pragma unroll 1
            for (int s = 0; s < 64; ++s) gmax = fmaxf(gmax, blast - sc_bc[s] + sc_ii[s]);
            const float mnew = fmaxf(blast + mst, gmax);
#pragma unroll 1
            for (int s = 0; s < 64; ++s) sc_ws[s] = __expf(blast - sc_bc[s] + sc_ii[s] - mnew);
            sc_misc[1] = __expf(blast + mst - mnew); sc_misc[2] = mnew; }
        __syncthreads();
#pragma unroll 1
        for (int idx = tid; idx < 64 * 64; idx += 512) { const int t = idx >> 6, s = idx & 63; float v = 0.f;
            if (s <= t) { const LAS f32x4* qp = (const LAS f32x4*)(Qs + t * MLP); const LAS f32x4* kp = (const LAS f32x4*)(Ks + s * MLP); float d0 = 0.f;
#pragma unroll 8
                for (int d = 0; d < 32; ++d) { const f32x4 a = qp[d], k = kp[d]; d0 += a.x * k.x + a.y * k.y + a.z * k.z + a.w * k.w; }
                v = d0 * __expf(sc_bc[t] - sc_bc[s] + sc_ii[s] - sc_mt[t]); }
            Ss[t * 65 + s] = v; }
        __syncthreads();
        if (tid < 64) { const int t = tid; float den = 0.f;
#pragma unroll 4
            for (int s = 0; s < 64; ++s) den += Ss[t * 65 + s];
            float qn = 0.f;
#pragma unroll 4
            for (int d = 0; d < 128; ++d) qn += Qs[t * MLP + d] * nvec[d];
            den += sc_wi[t] * qn; sc_rd[t] = 1.0f / fmaxf(fabsf(den), __expf(-sc_mt[t])); }
#pragma unroll 1
        for (int t = 0; t < 64; ++t) { const LAS f32x4* qp = (const LAS f32x4*)(Qs + t * MLP + 32 * dq); float p = 0.f;
#pragma unroll
            for (int i = 0; i < 8; ++i) { const f32x4 a = qp[i]; p += a.x * C[4 * i] + a.y * C[4 * i + 1] + a.z * C[4 * i + 2] + a.w * C[4 * i + 3]; }
            p += __shfl_xor(p, 1); p += __shfl_xor(p, 2);
            if ((t & 3) == dq) HI[t * MLP + e] = p; }
        __syncthreads();
#pragma unroll 1
        for (int j = 0; j < 16; ++j) { const int t = 4 * j + dq; float a = 0.f;
#pragma unroll 4
            for (int s2 = 0; s2 < 64; ++s2) a += Ss[t * 65 + s2] * Vs[s2 * MLP + e];
            Hs[t * MLP + e] = (a + sc_wi[t] * HI[t * MLP + e]) * sc_rd[t]; }
        __syncthreads();
#pragma unroll 1
        for (int rr = 0; rr < 8; ++rr) { const int t = wave * 8 + rr; const float h0 = Hs[t * MLP + lane], h1 = Hs[t * MLP + 64 + lane];
            const float ss = wave_sum(h0 * h0 + h1 * h1); const float rs = rsqrtf(ss * (1.0f / 128.0f) + HEAD_EPS);
            const bf16* zr = F.Z + (rowb + t) * ZP + ZOM + h * 128; const float o0 = bf2f(zr[lane]), o1 = bf2f(zr[64 + lane]);
            const float y0 = h0 * rs * F.g_mh[l * 512 + h * 128 + lane] / (1.0f + __expf(-o0)), y1 = h1 * rs * F.g_mh[l * 512 + h * 128 + 64 + lane] / (1.0f + __expf(-o1));
            bf16* mo = F.MIX + (rowb + t) * DM + h * 128; mo[lane] = (bf16)(pg8::cvt_pk_bf16(y0, 0.f) & 0xffffu); mo[64 + lane] = (bf16)(pg8::cvt_pk_bf16(y1, 0.f) & 0xffffu); }
        { const float decay = sc_misc[1];
#pragma unroll
          for (int i = 0; i < 32; ++i) C[i] *= decay;
#pragma unroll 2
          for (int s = 0; s < 64; ++s) { const float ve = sc_ws[s] * Vs[s * MLP + e]; const LAS f32x4* kp = (const LAS f32x4*)(Ks + s * MLP + 32 * dq);
#pragma unroll
              for (int i = 0; i < 8; ++i) { const f32x4 k = kp[i]; C[4 * i] += ve * k.x; C[4 * i + 1] += ve * k.y; C[4 * i + 2] += ve * k.z; C[4 * i + 3] += ve * k.w; } }
          if (tid < 128) { float nn = decay * nvec[tid];
#pragma unroll 4
              for (int s = 0; s < 64; ++s) nn += sc_ws[s] * Ks[s * MLP + tid]; nvec[tid] = nn; }
          if (tid == 0) sc_misc[0] = sc_misc[2]; }
        __syncthreads();
    }
}


__global__ void __launch_bounds__(512) k_mlstm_naive(Args args, int l) {
    extern __shared__ __attribute__((aligned(16))) unsigned char lds[];
    Frame F; frame_init(F, args, lds);
    mlstm_naive_unit(F, l, (int)blockIdx.x >> 2, (int)blockIdx.x & 3);
}
__global__ void __launch_bounds__(512) k_attn_naive(Args args, int l) {
    extern __shared__ __attribute__((aligned(16))) unsigned char lds[];
    Frame F; frame_init(F, args, lds);
    const float lam_init = (l == 0) ? 0.20000000000000007f : (l == 1) ? 0.35550906759096934f : (l == 2) ? 0.4707130183435842f : 0.5560582041556406f;
    const float lam = layer_lambda(F, l, lam_init);
    const int u = (int)blockIdx.x; const int qb = 15 - (u >> 6), bh = u & 63;
    attn_naive_unit(F, l, bh >> 2, bh & 3, qb, lam, lam_init);
}

__device__ __forceinline__ void final_norm(Frame& F) {
    const int gw = F.vcu * NWAVES + F.wave, NGW = F.G * NWAVES;
    f32x4 g[4];
#pragma unroll
    for (int j = 0; j < 4; ++j) g[j] = ((const GAS f32x4*)F.g_final)[F.lane + 64 * j];
    for (int m = gw; m < M; m += NGW) {
        GAS f32x4* xr = (GAS f32x4*)(F.out + (size_t)m * DM) + F.lane;
        f32x4 v[4]; float s = 0.f;
#pragma unroll
        for (int j = 0; j < 4; ++j) { v[j] = xr[64 * j]; s += (v[j].x * v[j].x + v[j].y * v[j].y) + (v[j].z * v[j].z + v[j].w * v[j].w); }
        const float rs = rsqrtf(wave_sum(s) * (1.0f / DM) + EPS);
#pragma unroll
        for (int j = 0; j < 4; ++j) xr[64 * j] = v[j] * rs * g[j];
    }
}

__global__ void __launch_bounds__(NWAVES * 64, 2) trunk_fwd(Args args) {
    extern __shared__ __attribute__((aligned(16))) unsigned char lds[];
    Frame F; frame_init(F, args, lds);
    for (int u = F.tid; u < (LDS_BYTES - LDSCTL_OFF) / 4; u += NWAVES * 64) ((LAS unsigned*)(F.lds + LDSCTL_OFF))[u] = 0u;
    __syncthreads();
#if MK_ONE_LAUNCH
    XcdBarrier bar = xcd_barrier_post((unsigned*)(F.ctl + CW_BAR), F.MISC + 8);
#define GRID_BAR() xcd_barrier(bar)
#else
#define GRID_BAR() do {} while (0)
#endif
    const int lo = args.ph_lo, hi = args.ph_hi;
#define IN(k) (lo <= (k) && (k) < hi)
#define BOTH(k) (IN(k) && IN((k) + 1))

    if (IN(0)) { p0_prologue(F); VM_WAIT(); __syncthreads(); if (BOTH(0)) GRID_BAR(); }

    for (int l = 0; l < NL; ++l) {
        const int pb = 1 + 5 * l;
        const float lam_init = (l == 0) ? 0.20000000000000007f : (l == 1) ? 0.35550906759096934f : (l == 2) ? 0.4707130183435842f : 0.5560582041556406f;
        if (IN(pb)) {
            gates_phase(F, l);
            pg8::Gemm g{F.XB, F.Win + (size_t)l * ZP * DM, M, ZP, DM}; pg8::StaticOrder S; S.init(M, ZP, F.G, (int)blockIdx.x);
            pg8::EpiIn E{F.Z, ZP, F.rowss, F.cosT, F.sinT, EPS, C2};
            pg8::gemm_phase<pg8::EpiIn, pg8::StaticOrder, true, true>(F.lds + RING_OFF, g, S, E);
            if (BOTH(pb)) GRID_BAR();
        }
        if (IN(pb + 1)) {
            if (BOTH(pb + 1)) GRID_BAR();
        }
        if (IN(pb + 2)) {
            pg8::Gemm g{F.MIX, F.Wout + (size_t)l * DM * DM, M, DM, DM}; pg8::StaticOrder S; S.init(M, DM, F.G, (int)blockIdx.x);
            pg8::EpiRes E{l == 0 ? F.x : (const float*)F.out, F.out, F.XB, F.rowss};
            pg8::gemm_phase<pg8::EpiRes, pg8::StaticOrder, true, true>(F.lds + RING_OFF, g, S, E);
            if (BOTH(pb + 2)) GRID_BAR();
        }
        if (IN(pb + 3)) {
            pg8::Gemm g{F.XB, F.Wgu + (size_t)l * NGU * DM, M, NGU, DM}; pg8::StaticOrder S; S.init(M, NGU, F.G, (int)blockIdx.x);
            pg8::EpiGU E{F.Z, FF, F.rowss, EPS};
            pg8::gemm_phase<pg8::EpiGU, pg8::StaticOrder, true, true>(F.lds + RING_OFF, g, S, E);
            if (BOTH(pb + 3)) GRID_BAR();
        }
        if (IN(pb + 4)) {
            pg8::Gemm g{F.Z, F.Wdn + (size_t)l * DM * FF, M, DM, FF}; pg8::StaticOrder S; S.init(M, DM, F.G, (int)blockIdx.x);
            pg8::EpiRes E{F.out, F.out, F.XB, F.rowss};
            pg8::gemm_phase<pg8::EpiRes, pg8::StaticOrder, true, true>(F.lds + RING_OFF, g, S, E);
            if (BOTH(pb + 4)) GRID_BAR();
        }
    }
    if (IN(N_PHASES - 1)) final_norm(F);
#undef IN
#undef BOTH
}

extern "C" void kernel_launch(void* const* d_in, const int* in_sizes, int n_in, void* d_out, int out_size, void* d_ws, size_t ws_size, hipStream_t stream) {
    static int grid = 0;
    if (grid == 0) {
        if (n_in != 18 || out_size != M * DM || ws_size < WS_END) { fprintf(stderr, "kernel_launch: unexpected shapes (n_in %d, out %d, ws %zu, need %zu)\n", n_in, out_size, ws_size, (size_t)WS_END); grid = -1; return; }
        int dev = 0, cus = 0;
        if (hipGetDevice(&dev) != hipSuccess || hipDeviceGetAttribute(&cus, hipDeviceAttributeMultiprocessorCount, dev) != hipSuccess) { grid = -1; return; }
        if (hipFuncSetAttribute((const void*)trunk_fwd, hipFuncAttributeMaxDynamicSharedMemorySize, LDS_BYTES) != hipSuccess) { grid = -1; return; }
        if (hipFuncSetAttribute((const void*)k_mlstm_naive, hipFuncAttributeMaxDynamicSharedMemorySize, 160000) != hipSuccess || hipFuncSetAttribute((const void*)k_attn_naive, hipFuncAttributeMaxDynamicSharedMemorySize, 131072) != hipSuccess) { grid = -1; return; }
        int per_cu = 0;
        if (hipOccupancyMaxActiveBlocksPerMultiprocessor(&per_cu, (const void*)trunk_fwd, NWAVES * 64, LDS_BYTES) != hipSuccess || per_cu < 1) fprintf(stderr, "kernel_launch: occupancy query says %d\n", per_cu);
        (void)hipGetLastError();
        grid = cus;
    }
    if (grid < 0) return;
    (void)in_sizes;
    if (hipMemsetAsync((char*)d_ws + WS_CTL, 0, CTL_ZERO_BYTES, stream) != hipSuccess) return;
    Args a{};
    for (int i = 0; i < 18; ++i) a.in[i] = (const float*)d_in[i];
    a.out = (float*)d_out; a.ws = (unsigned char*)d_ws;
#if MK_ONE_LAUNCH
    a.ph_lo = 0; a.ph_hi = N_PHASES;
    hipLaunchKernelGGL(trunk_fwd, dim3(grid), dim3(NWAVES * 64), LDS_BYTES, stream, a);
#else
    for (int p = 0; p < N_PHASES; ++p) {
        if (p >= 1 && p < N_PHASES - 1 && (p - 1) % 5 == 1) { const int l = (p - 1) / 5;
            hipLaunchKernelGGL(k_mlstm_naive, dim3(64), dim3(512), 160000, stream, a, l);
            hipLaunchKernelGGL(k_attn_naive, dim3(1024), dim3(512), 131072, stream, a, l);
            continue; }
        a.ph_lo = p; a.ph_hi = p + 1; hipLaunchKernelGGL(trunk_fwd, dim3(grid), dim3(NWAVES * 64), LDS_BYTES, stream, a); }
#endif
}
```

```cpp
#include <hip/hip_runtime.h>
#ifndef ATTN_ORDER
#define ATTN_ORDER 1
#endif
#include <cstdio>
#include <cstdint>
#include <cmath>
namespace pg8 {
#define PG8_LAS __attribute__((address_space(3)))
typedef unsigned short bf16_t;
typedef short bf16x8 __attribute__((ext_vector_type(8)));
typedef float f32x4 __attribute__((ext_vector_type(4)));
typedef unsigned u32x4 __attribute__((ext_vector_type(4)));
constexpr int BM = 256, BK = 64, HALF = 128, HTB = HALF * BK * 2  , STAGE_BYTES = 8 * HTB, NXCD = 8, WGM = 8;

__host__ __device__ __forceinline__ int lds_byte(int r, int c) { const int st = (r >> 4) * 2 + (c >> 5), rr = r & 15, cc = c & 31, ob = rr * 64 + cc * 2; return st * 1024 + (ob ^ (((ob >> 9) & 1) << 5)); }
__host__ __device__ __forceinline__ void stage_rc(int b, int& R, int& C) { const int st = b / 1024, sb = b % 1024, swz = sb ^ (((sb >> 9) & 1) << 5); R = (st >> 1) * 16 + swz / 64; C = (st & 1) * 32 + (swz % 64) / 2; }
__host__ __device__ __forceinline__ int perm32(int rho) { const int n = rho >> 4, i = rho & 15; return 8 * (i >> 2) + 4 * n + (i & 3); }

struct Unit { int pm, pn; };
struct Gemm { const bf16_t* A; const bf16_t* Bt; int M, N, K; };

struct StaticOrder {
    int nM, nN, nwg, G, c;
    __host__ __device__ void init(int M, int N, int G_, int c_) { nM = M / BM; nN = N / BM; nwg = nM * nN; G = G_; c = c_; }
    __host__ __device__ bool next(int i, Unit& u) const {
        const long L = (long)i * G + c; if (L >= nwg) return false;
        int wgid = (int)L; { const int q = nwg / NXCD, r = nwg % NXCD, xcd = wgid % NXCD, off = wgid / NXCD; wgid = (xcd < r ? xcd * (q + 1) : r * (q + 1) + (xcd - r) * q) + off; }
        const int nig = WGM * nN, gid = wgid / nig, fm = gid * WGM, gsz = (nM - fm) < WGM ? (nM - fm) : WGM;
        u.pm = fm + ((wgid % nig) % gsz); u.pn = (wgid % nig) / gsz; return true;
    }
    __device__ __forceinline__ void a_ready(const Unit&) const {}
    __device__ __forceinline__ void done(const Unit&) const {}
};

typedef float f32x2_c __attribute__((ext_vector_type(2))); typedef __bf16 bf16x2_c __attribute__((ext_vector_type(2)));
__device__ __forceinline__ unsigned cvt_pk_bf16(float lo, float hi) { f32x2_c v = {lo, hi}; bf16x2_c b = __builtin_convertvector(v, bf16x2_c); return __builtin_bit_cast(unsigned, b); }
typedef float f32x2 __attribute__((ext_vector_type(2)));
struct ReverseOrder : StaticOrder {
    int nr;
    __host__ __device__ void init(int M, int N, int G_, int c_) { StaticOrder::init(M, N, G_, c_); nr = (nwg - c + G - 1) / G; }
    __host__ __device__ bool next(int i, Unit& u) const { return (i < nr) && StaticOrder::next(nr - 1 - i, u); }
};
constexpr int ROWSS_SLOTS = 16;
__device__ __forceinline__ float row_rstd(const float* rowss, int row, int fq, float eps) {
    const f32x4 q = *(const f32x4*)(rowss + (size_t)row * ROWSS_SLOTS + fq * 4);
    float s = (q[0] + q[1]) + (q[2] + q[3]);
    s += __shfl_xor(s, 16); s += __shfl_xor(s, 32);
    return __builtin_amdgcn_rsqf(s * (1.0f / 1024.0f) + eps);
}
struct RstdTab { const PG8_LAS float* tab; int pm0; __device__ __forceinline__ float get(int pm, int row_in_panel) const { return tab[((pm - pm0) >> 3) * BM + row_in_panel]; } };
typedef _Float16 f16x8 __attribute__((ext_vector_type(8)));
typedef float f32x8 __attribute__((ext_vector_type(8)));
struct EpiIn {
    static constexpr bool PERM = true, AFTER_DRAIN = false;
    bf16_t* Z; int ZP; RstdTab rt; const _Float16* rot  ; float qscale;
    __device__ __forceinline__ void operator()(const f32x4 (&acc)[2][2][4][2], const Unit& u, int wr, int wc, int fr, int fq) const {
        const int row0 = u.pm * BM + wr * 64 + fr;
        if (u.pn >= 8 && u.pn < 12) {
            const bool isq = u.pn < 10; const int tile = isq ? u.pn - 8 : u.pn - 10;
            const int head = 2 * tile + (wc >> 1), cm = wc & 1;
            const int colbase = (isq ? 2048 : 2560) + head * 128 + cm * 64 + 8 * fq;
            const float sc = isq ? qscale : 1.f;
#pragma unroll
            for (int ai = 0; ai < 2; ++ai) {
                f16x8 tc[4], ts[4];
#pragma unroll
                for (int m = 0; m < 4; ++m) { const int pos = (row0 + ai * HALF + m * 16) & 2047; const _Float16* tp = rot + ((size_t)pos * 4 + fq) * 16; tc[m] = *(const f16x8*)tp; ts[m] = *(const f16x8*)(tp + 8); }
#pragma unroll
                for (int m = 0; m < 4; ++m) {
                    const int row = row0 + ai * HALF + m * 16; const float rs = rt.get(u.pm, row - u.pm * BM) * sc;
                    const f32x8 cf = __builtin_convertvector(tc[m], f32x8), sf = __builtin_convertvector(ts[m], f32x8);
                    const f32x4 c0 = {cf[0], cf[1], cf[2], cf[3]}, c1 = {cf[4], cf[5], cf[6], cf[7]}, s0 = {sf[0], sf[1], sf[2], sf[3]}, s1 = {sf[4], sf[5], sf[6], sf[7]};
                    const f32x4 a0 = acc[ai][0][m][0] * rs, a1 = acc[ai][0][m][1] * rs, b0 = acc[ai][1][m][0] * rs, b1 = acc[ai][1][m][1] * rs;
                    const f32x4 o10 = a0 * c0 - b0 * s0, o11 = a1 * c1 - b1 * s1, o20 = b0 * c0 + a0 * s0, o21 = b1 * c1 + a1 * s1;
                    bf16_t* rowp = Z + (size_t)row * ZP + colbase;
                    u32x4 w; w.x = cvt_pk_bf16(o10[0], o10[1]); w.y = cvt_pk_bf16(o10[2], o10[3]); w.z = cvt_pk_bf16(o11[0], o11[1]); w.w = cvt_pk_bf16(o11[2], o11[3]);
                    *(u32x4*)rowp = w;
                    w.x = cvt_pk_bf16(o20[0], o20[1]); w.y = cvt_pk_bf16(o20[2], o20[3]); w.z = cvt_pk_bf16(o21[0], o21[1]); w.w = cvt_pk_bf16(o21[2], o21[3]);
                    *(u32x4*)(rowp + 32) = w;
                }
            }
        } else {
            const int col0 = u.pn * BM + wc * 32 + 8 * fq;
#pragma unroll
            for (int ai = 0; ai < 2; ++ai)
#pragma unroll
                for (int m = 0; m < 4; ++m) {
                    const int row = row0 + ai * HALF + m * 16; const float rs = rt.get(u.pm, row - u.pm * BM);
                    bf16_t* rowp = Z + (size_t)row * ZP + col0;
#pragma unroll
                    for (int bj = 0; bj < 2; ++bj) { const f32x4 v0 = acc[ai][bj][m][0] * rs, v1 = acc[ai][bj][m][1] * rs;
                        u32x4 w; w.x = cvt_pk_bf16(v0[0], v0[1]); w.y = cvt_pk_bf16(v0[2], v0[3]); w.z = cvt_pk_bf16(v1[0], v1[1]); w.w = cvt_pk_bf16(v1[2], v1[3]);
                        *(u32x4*)(rowp + bj * HALF) = w; }
                }
        }
    }
};
template <int NORSTD = 0> struct EpiGU {
    static constexpr bool PERM = true, AFTER_DRAIN = false;
    bf16_t* H; int HP; RstdTab rt;
    __device__ __forceinline__ void operator()(const f32x4 (&acc)[2][2][4][2], const Unit& u, int wr, int wc, int fr, int fq) const {
        const int row0 = u.pm * BM + wr * 64 + fr; const int col0 = u.pn * HALF + wc * 32 + 8 * fq;
        if (NORSTD == 2) {
#pragma unroll
            for (int ai = 0; ai < 2; ++ai)
#pragma unroll
                for (int bj = 0; bj < 2; ++bj)
#pragma unroll
                    for (int m = 0; m < 4; ++m) asm volatile("" :: "v"(acc[ai][bj][m][0]), "v"(acc[ai][bj][m][1]));
            return; }
#pragma unroll
        for (int ai = 0; ai < 2; ++ai)
#pragma unroll
            for (int m = 0; m < 4; ++m) {
                const int row = row0 + ai * HALF + m * 16; const float rs = NORSTD ? 1.0f : rt.get(u.pm, row - u.pm * BM);
                f32x4 hv[2]; const float rsn = rs * -1.4426950408889634f, rs2 = rs * rs;
#pragma unroll
                for (int n = 0; n < 2; ++n) { const f32x4 a = acc[ai][0][m][n], b = acc[ai][1][m][n]; const f32x4 t = a * rsn;
                    const f32x4 e = {__builtin_amdgcn_exp2f(t[0]), __builtin_amdgcn_exp2f(t[1]), __builtin_amdgcn_exp2f(t[2]), __builtin_amdgcn_exp2f(t[3])};
                    const f32x4 d = e + 1.0f; const f32x4 r = {__builtin_amdgcn_rcpf(d[0]), __builtin_amdgcn_rcpf(d[1]), __builtin_amdgcn_rcpf(d[2]), __builtin_amdgcn_rcpf(d[3])};
                    hv[n] = ((a * b) * rs2) * r; }
                u32x4 w; w.x = cvt_pk_bf16(hv[0][0], hv[0][1]); w.y = cvt_pk_bf16(hv[0][2], hv[0][3]); w.z = cvt_pk_bf16(hv[1][0], hv[1][1]); w.w = cvt_pk_bf16(hv[1][2], hv[1][3]);
                *(u32x4*)(H + (size_t)row * HP + col0) = w;
            }
    }
};
struct EpiRes {
    static constexpr bool PERM = true, AFTER_DRAIN = false;
    bf16_t* xb; float* rowss;
    __device__ __forceinline__ void operator()(const f32x4 (&acc)[2][2][4][2], const Unit& u, int wr, int wc, int fr, int fq) const {
        const int row0 = u.pm * BM + wr * 64 + fr; const int col0 = u.pn * BM + wc * 32 + 8 * fq;
#pragma unroll
        for (int ai = 0; ai < 2; ++ai) {
        u32x4 rres[4][2];
#pragma unroll
            for (int m = 0; m < 4; ++m)
#pragma unroll
                for (int bj = 0; bj < 2; ++bj) rres[m][bj] = *(const u32x4*)(xb + (size_t)(row0 + ai * HALF + m * 16) * 1024 + col0 + bj * HALF);
#pragma unroll
            for (int m = 0; m < 4; ++m) {
                const int row = row0 + ai * HALF + m * 16; const size_t off = (size_t)row * 1024 + col0; float ss = 0.f;
#pragma unroll
                for (int bj = 0; bj < 2; ++bj) {
                    const u32x4 r = rres[m][bj];
                    const f32x4 r0 = {__uint_as_float(r.x << 16), __uint_as_float(r.x & 0xffff0000u), __uint_as_float(r.y << 16), __uint_as_float(r.y & 0xffff0000u)};
                    const f32x4 r1 = {__uint_as_float(r.z << 16), __uint_as_float(r.z & 0xffff0000u), __uint_as_float(r.w << 16), __uint_as_float(r.w & 0xffff0000u)};
                    const f32x4 v0 = r0 + acc[ai][bj][m][0], v1 = r1 + acc[ai][bj][m][1];
                    u32x4 w; w.x = cvt_pk_bf16(v0[0], v0[1]); w.y = cvt_pk_bf16(v0[2], v0[3]); w.z = cvt_pk_bf16(v1[0], v1[1]); w.w = cvt_pk_bf16(v1[2], v1[3]);
                    *(u32x4*)(xb + off + bj * HALF) = w;
                    ss += (v0[0] * v0[0] + v0[1] * v0[1]) + (v0[2] * v0[2] + v0[3] * v0[3]) + (v1[0] * v1[0] + v1[1] * v1[1]) + (v1[2] * v1[2] + v1[3] * v1[3]);
                }
                ss += __shfl_xor(ss, 16); ss += __shfl_xor(ss, 32);
                if (fq == 0) rowss[(size_t)row * ROWSS_SLOTS + u.pn * 4 + wc] = ss;
            }
        }
    }
};

template <class Epi, class Sched, bool ALIGN_EPI = false, bool SP2 = false>
__device__ __forceinline__ void gemm_phase(PG8_LAS unsigned char* lds, const Gemm g, const Sched& S, const Epi& E) {
    int tid_ = threadIdx.x; asm volatile("" : "+v"(tid_));
    const int tid = tid_, wid = __builtin_amdgcn_readfirstlane(tid >> 6), lane = tid & 63, wr = wid >> 2, wc = wid & 3, fr = lane & 15, fq = lane >> 4;
    const int K = g.K, nt = K / BK;
    unsigned voffA[2], voffB[2];
#pragma unroll
    for (int i = 0; i < 2; ++i) { int R, C; stage_rc(tid * 16 + i * 8192, R, C); const int Rb = Epi::PERM ? ((R & ~31) + perm32(R & 31)) : R;
        voffA[i] = (unsigned)(R * K + C) * 2u; voffB[i] = (unsigned)(Rb * K + C) * 2u; }
    const size_t kstep = (size_t)(BK * 2);
    const size_t hstep = (size_t)HALF * K * 2;
    const size_t tstep = 2 * hstep;
    const unsigned ldsw = (unsigned)wid * 1024u;
    const int aoff = lds_byte(wr * 64 + fr, fq * 8), boff = lds_byte(wc * 32 + fr, fq * 8);
#define PG8_SA(b, h) (((b) * 2 + (h)) * HTB)
#define PG8_SB(b, h) ((4 + (b) * 2 + (h)) * HTB)
#define PG8_STAGE(bufoff, gbase, voff) do { _Pragma("unroll") for (int _i = 0; _i < 2; ++_i) \
        __builtin_amdgcn_global_load_lds((const unsigned*)((const char*)(gbase) + (voff)[_i]), (PG8_LAS unsigned*)(lds + (bufoff) + ldsw + _i * 8192), 16, 0, 0); } while (0)
#define PG8_LDA(dst, b, h) do { _Pragma("unroll") for (int m = 0; m < 4; ++m) _Pragma("unroll") for (int k = 0; k < 2; ++k) dst[m][k] = *(const PG8_LAS bf16x8*)(lds + PG8_SA(b, h) + aoff + m * 2048 + k * 1024); } while (0)
#define PG8_LDB(dst, b, h) do { _Pragma("unroll") for (int n = 0; n < 2; ++n) _Pragma("unroll") for (int k = 0; k < 2; ++k) dst[n][k] = *(const PG8_LAS bf16x8*)(lds + PG8_SB(b, h) + boff + n * 2048 + k * 1024); } while (0)
#define PG8_MMA(ai, bj, At, Bt) do { __builtin_amdgcn_s_setprio(1); _Pragma("unroll") for (int m = 0; m < 4; ++m) _Pragma("unroll") for (int n = 0; n < 2; ++n) _Pragma("unroll") for (int k = 0; k < 2; ++k) \
        acc[ai][bj][m][n] = __builtin_amdgcn_mfma_f32_16x16x32_bf16(Bt[n][k], At[m][k], acc[ai][bj][m][n], 0, 0, 0); __builtin_amdgcn_s_setprio(0); } while (0)
#define PG8_WAIT_V(n) asm volatile("s_waitcnt vmcnt(" #n ")" ::: "memory")
#define PG8_WAIT_L(n) asm volatile("s_waitcnt lgkmcnt(" #n ")" ::: "memory")
#define PG8_BAR __builtin_amdgcn_s_barrier()
#define PG8_SCHED __builtin_amdgcn_sched_barrier(0)
    Unit cur, nxt; int ui = 0;
    if (!S.next(0, cur)) return;
    f32x4 acc[2][2][4][2];
#pragma unroll
    for (int a = 0; a < 2; ++a)
#pragma unroll
        for (int b = 0; b < 2; ++b)
#pragma unroll
            for (int m = 0; m < 4; ++m)
#pragma unroll
                for (int n = 0; n < 2; ++n) acc[a][b][m][n] = (f32x4){0.f, 0.f, 0.f, 0.f};
    bf16x8 At[4][2], B0[2][2], B1[2][2];
    const char* cA = (const char*)g.A + (size_t)cur.pm * tstep; const char* cB = (const char*)g.Bt + (size_t)cur.pn * tstep;
    S.a_ready(cur);
    if constexpr (SP2) {
        PG8_STAGE(PG8_SB(0, 0), cB, voffB); PG8_STAGE(PG8_SB(0, 1), cB + hstep, voffB); PG8_STAGE(PG8_SA(0, 0), cA, voffA); PG8_STAGE(PG8_SA(0, 1), cA + hstep, voffA);
        if (wr == 1) PG8_BAR;
        PG8_WAIT_V(2); PG8_BAR;
        PG8_STAGE(PG8_SB(1, 0), cB + kstep, voffB); PG8_STAGE(PG8_SA(1, 0), cA + kstep, voffA); PG8_STAGE(PG8_SB(1, 1), cB + hstep + kstep, voffB);
        PG8_WAIT_V(6); PG8_BAR;
    } else {
        PG8_STAGE(PG8_SB(0, 0), cB, voffB); PG8_STAGE(PG8_SA(0, 0), cA, voffA); PG8_STAGE(PG8_SB(0, 1), cB + hstep, voffB); PG8_STAGE(PG8_SA(0, 1), cA + hstep, voffA);
        if (wr == 1) PG8_BAR;
        PG8_WAIT_V(4); PG8_BAR;
        PG8_STAGE(PG8_SB(1, 0), cB + kstep, voffB); PG8_STAGE(PG8_SA(1, 0), cA + kstep, voffA); PG8_STAGE(PG8_SB(1, 1), cB + hstep + kstep, voffB);
        PG8_WAIT_V(6); PG8_BAR;
    }
    for (;;) {
        const bool has_next = S.next(ui + 1, nxt);
        const char* nA = has_next ? (const char*)g.A + (size_t)nxt.pm * tstep : cA; const char* nB = has_next ? (const char*)g.Bt + (size_t)nxt.pn * tstep : cB;
        for (int t = 0; t < nt; t += 2) {
            const bool last = (t == nt - 2);
            const char* a1 = cA + (size_t)(t + 1) * kstep;
            const char* a2 = last ? nA : cA + (size_t)(t + 2) * kstep; const char* b2 = last ? nB : cB + (size_t)(t + 2) * kstep;
            const char* a3 = a2 + kstep; const char* b3 = b2 + kstep;
            if (last && has_next) S.a_ready(nxt);
            if constexpr (SP2) {
            PG8_LDB(B0, 0, 0); PG8_LDB(B1, 0, 1); PG8_SCHED; PG8_LDA(At, 0, 0); PG8_STAGE(PG8_SA(1, 1), a1 + hstep, voffA);
            PG8_WAIT_V(8); PG8_WAIT_L(0); PG8_BAR; PG8_MMA(0, 0, At, B0); PG8_MMA(0, 1, At, B1); PG8_BAR; PG8_SCHED;
            PG8_LDA(At, 0, 1); PG8_STAGE(PG8_SB(0, 0), b2, voffB); PG8_STAGE(PG8_SB(0, 1), b2 + hstep, voffB); PG8_STAGE(PG8_SA(0, 0), a2, voffA);
            PG8_WAIT_V(8); PG8_WAIT_L(0); PG8_BAR; PG8_MMA(1, 0, At, B0); PG8_MMA(1, 1, At, B1); PG8_BAR; PG8_SCHED;
            PG8_LDB(B0, 1, 0); PG8_LDB(B1, 1, 1); PG8_SCHED; PG8_LDA(At, 1, 0); PG8_STAGE(PG8_SA(0, 1), a2 + hstep, voffA);
            PG8_WAIT_V(8); PG8_WAIT_L(0); PG8_BAR; PG8_MMA(0, 0, At, B0); PG8_MMA(0, 1, At, B1); PG8_BAR; PG8_SCHED;
            PG8_LDA(At, 1, 1); PG8_STAGE(PG8_SB(1, 0), b3, voffB); PG8_STAGE(PG8_SB(1, 1), b3 + hstep, voffB); PG8_STAGE(PG8_SA(1, 0), a3, voffA);
            PG8_WAIT_V(8); PG8_WAIT_L(0); PG8_BAR; PG8_MMA(1, 0, At, B0); PG8_MMA(1, 1, At, B1); PG8_BAR; PG8_SCHED;
            } else {
            PG8_LDB(B0, 0, 0); PG8_SCHED; PG8_LDA(At, 0, 0); PG8_STAGE(PG8_SA(1, 1), a1 + hstep, voffA);
            PG8_WAIT_L(8); PG8_BAR; PG8_WAIT_L(0); PG8_MMA(0, 0, At, B0); PG8_BAR; PG8_SCHED;
            PG8_LDB(B1, 0, 1); PG8_STAGE(PG8_SB(0, 0), b2, voffB);
            PG8_BAR; PG8_WAIT_L(0); PG8_MMA(0, 1, At, B1); PG8_BAR;
            PG8_LDA(At, 0, 1); PG8_STAGE(PG8_SA(0, 0), a2, voffA);
            PG8_BAR; PG8_WAIT_L(0); PG8_MMA(1, 0, At, B0); PG8_BAR; PG8_SCHED;
            PG8_STAGE(PG8_SB(0, 1), b2 + hstep, voffB);
            PG8_WAIT_V(6); PG8_BAR; PG8_MMA(1, 1, At, B1); PG8_BAR;
            PG8_LDB(B0, 1, 0); PG8_SCHED; PG8_LDA(At, 1, 0); PG8_STAGE(PG8_SA(0, 1), a2 + hstep, voffA);
            PG8_WAIT_L(8); PG8_BAR; PG8_WAIT_L(0); PG8_MMA(0, 0, At, B0); PG8_BAR; PG8_SCHED;
            PG8_LDB(B1, 1, 1); PG8_STAGE(PG8_SB(1, 0), b3, voffB);
            PG8_BAR; PG8_WAIT_L(0); PG8_MMA(0, 1, At, B1); PG8_BAR;
            PG8_LDA(At, 1, 1); PG8_STAGE(PG8_SA(1, 0), a3, voffA);
            PG8_BAR; PG8_WAIT_L(0); PG8_MMA(1, 0, At, B0); PG8_BAR; PG8_SCHED;
            PG8_STAGE(PG8_SB(1, 1), b3 + hstep, voffB);
            PG8_WAIT_V(6); PG8_BAR; PG8_MMA(1, 1, At, B1); PG8_BAR;
            }
        }
        if constexpr (ALIGN_EPI) { if (wr == 0) PG8_BAR; }
        if constexpr (!Epi::AFTER_DRAIN) { E(acc, cur, wr, wc, fr, fq); S.done(cur); }
        if (!has_next) break;
#pragma unroll
        for (int a = 0; a < 2; ++a)
#pragma unroll
            for (int b = 0; b < 2; ++b)
#pragma unroll
                for (int m = 0; m < 4; ++m)
#pragma unroll
                    for (int n = 0; n < 2; ++n) acc[a][b][m][n] = (f32x4){0.f, 0.f, 0.f, 0.f};
        cur = nxt; cA = nA; cB = nB; ++ui;
        if constexpr (ALIGN_EPI) { if (wr == 1) PG8_BAR; }
    }
    PG8_WAIT_V(0);
    if constexpr (!ALIGN_EPI) { if (wr == 0) PG8_BAR; }
    PG8_BAR;
    if constexpr (Epi::AFTER_DRAIN) { E.fused(acc, cur, wr, wc, fr, fq, lds, wid, lane); S.done(cur); }
#undef PG8_SA
#undef PG8_SB
#undef PG8_STAGE
#undef PG8_LDA
#undef PG8_LDB
#undef PG8_MMA
#undef PG8_WAIT_V
#undef PG8_WAIT_L
#undef PG8_BAR
#undef PG8_SCHED
}
}
#define GAS __attribute__((address_space(1)))
#define LAS __attribute__((address_space(3)))
typedef unsigned short bf16;
typedef unsigned v4u __attribute__((ext_vector_type(4)));
typedef float f32x4 __attribute__((ext_vector_type(4)));
typedef short bf16x8 __attribute__((ext_vector_type(8)));
typedef GAS unsigned gu32;
typedef GAS unsigned long long gu64;
#define RLX_AGENT __ATOMIC_RELAXED, __HIP_MEMORY_SCOPE_AGENT
#define LDS_WAIT() asm volatile("s_waitcnt lgkmcnt(0)" ::: "memory")
#define VM_WAIT() asm volatile("s_waitcnt vmcnt(0)" ::: "memory")
__device__ __forceinline__ unsigned long long rt() { return __builtin_amdgcn_s_memrealtime(); }
__device__ __forceinline__ unsigned f2bf(float f) { unsigned u = __builtin_bit_cast(unsigned, f); return (u + 0x7fffu + ((u >> 16) & 1u)) >> 16; }
__device__ __forceinline__ unsigned pk2(float lo, float hi) { return f2bf(lo) | (f2bf(hi) << 16); }

#define XB_TMO      128
#define XB_XCNT(j)  (256  + 64 * (j))
#define XB_XSUB(j)  (1280 + 64 * (j))
#define XB_XGEN(j)  (2304 + 64 * (j))
#define XB_TOP      3328
#define XB_TOPGEN   3392
#define XCD_BAR_WORDS 3456
#define XB_SPIN_CAP (1u << 18)

__device__ __forceinline__ unsigned xb_ld(unsigned* p)              { return __hip_atomic_load(p, __ATOMIC_RELAXED, __HIP_MEMORY_SCOPE_AGENT); }
__device__ __forceinline__ unsigned xb_add(unsigned* p, unsigned v) { return __hip_atomic_fetch_add(p, v, __ATOMIC_RELAXED, __HIP_MEMORY_SCOPE_AGENT); }
__device__ __forceinline__ unsigned xb_xcc_id() { return (unsigned)__builtin_amdgcn_s_getreg((3 << 11) | 20) & 0xFu; }
#define XB_SPIN(cond, bar) do { unsigned _sp = 0; while (cond) { __builtin_amdgcn_s_sleep(1); \
    if ((++_sp & 255u) == 0u) { if (xb_ld(&(bar)[XB_TMO])) break; if (_sp > XB_SPIN_CAP) { atomicAdd(&(bar)[XB_TMO], 1u); break; } } } } while (0)

struct XcdBarrier {
    unsigned* bar; unsigned x;
    volatile LAS unsigned* st;
};

__device__ __forceinline__ XcdBarrier xcd_barrier_post(unsigned* bar, volatile LAS unsigned* st) {
    XcdBarrier b; b.bar = bar; b.x = xb_xcc_id(); b.st = st;
    if (threadIdx.x == 0) (void)xb_add(&bar[XB_XCNT(b.x)], 1u);
    return b;
}
__device__ __forceinline__ void xcd_barrier_complete(unsigned* bar, unsigned x, unsigned& nloc, unsigned& nx) {
    const unsigned G = gridDim.x * gridDim.y * gridDim.z;
    unsigned sum, cnt, mine, sp = 0u;
    for (;;) {
        sum = 0u; cnt = 0u; mine = 0u;
#pragma unroll
        for (unsigned j = 0; j < 16; ++j) { const unsigned c = xb_ld(&bar[XB_XCNT(j)]); sum += c; cnt += (c > 0u) ? 1u : 0u; mine = (j == x) ? c : mine; }
        if (sum == G) break;
        __builtin_amdgcn_s_sleep(1);
        if ((++sp & 255u) == 0u) { if (xb_ld(&bar[XB_TMO])) break; if (sp > XB_SPIN_CAP) { atomicAdd(&bar[XB_TMO], 1u); break; } }
    }
    nloc = mine > 0u ? mine : 1u; nx = cnt > 0u ? cnt : 1u;
}

__device__ __forceinline__ void xcd_barrier(const XcdBarrier& b) {
    asm volatile("s_waitcnt vmcnt(0)" ::: "memory");
    __syncthreads();
    if (threadIdx.x == 0) {
        unsigned* bar = b.bar;
        __builtin_amdgcn_s_waitcnt(0);
        unsigned nloc = b.st[0], nx = b.st[1];
        if (nloc == 0u) { xcd_barrier_complete(bar, b.x, nloc, nx); b.st[0] = nloc; b.st[1] = nx; }
        const unsigned old = xb_add(&bar[XB_XSUB(b.x)], 1u);
        const unsigned gen = old / nloc;
        if (old + 1u == (gen + 1u) * nloc) {
            __builtin_amdgcn_fence(__ATOMIC_RELEASE, "agent");
            asm volatile("s_waitcnt vmcnt(0)" ::: "memory");
            const unsigned og = xb_add(&bar[XB_TOP], 1u);
            const unsigned tg = og / nx;
            if (og + 1u == (tg + 1u) * nx) xb_add(&bar[XB_TOPGEN], 1u);
            else XB_SPIN(xb_ld(&bar[XB_TOPGEN]) == tg, bar);
            __builtin_amdgcn_fence(__ATOMIC_ACQUIRE, "agent");
            xb_add(&bar[XB_XGEN(b.x)], 1u);
            asm volatile("s_waitcnt vmcnt(0)" ::: "memory");
        } else {
            XB_SPIN(xb_ld(&bar[XB_XGEN(b.x)]) == gen, bar);
            __builtin_amdgcn_fence(__ATOMIC_ACQUIRE, "agent");
            asm volatile("s_waitcnt vmcnt(0)" ::: "memory");
        }
    }
    __syncthreads();
}
#include <hip/hip_bf16.h>
#include <cmath>
namespace attn_body {
using bf16=__hip_bfloat16;
using bf16x8=__attribute__((ext_vector_type(8)))short;
using s16x4=__attribute__((ext_vector_type(4)))short;
using f32x16=__attribute__((ext_vector_type(16)))float;
using u32x4=__attribute__((ext_vector_type(4)))unsigned;
constexpr int SEQ=2048,D=64,DM=3584;
constexpr int NW=8,QBLK=32,QB=QBLK*NW,KVBLK=64,NQB=SEQ/QB;
__device__ __forceinline__ int crow(int r,int hi){return (r&3)+8*(r>>2)+4*hi;}
#define SBAR() __builtin_amdgcn_sched_barrier(0)
__device__ __forceinline__ void cmask(f32x16&p0,f32x16&p1,int jb,int qrel,int hi){
  const float NEG=-INFINITY; int kb=64*jb+4*hi;
  #pragma unroll
  for(int r=0;r<16;++r){int kv=kb+(r&3)+8*(r>>2); if(kv>qrel)p0[r]=NEG; if(kv+32>qrel)p1[r]=NEG;}
}

constexpr int NSLOT=3, SLOTB=8192;
constexpr int LDS_K=0, LDS_V=NSLOT*SLOTB, LDS_WS=3*NSLOT*SLOTB, LDS_ST=LDS_WS+NW*64*4, LDS_BYTES=LDS_ST+NW*8192;
constexpr float C2=0.125f*1.4426950408889634f;
__device__ __forceinline__ void glds16(const void*gsrc,unsigned lds_dst){unsigned keep;
  asm volatile("s_mov_b32 %0, m0\n\ts_mov_b32 m0, %2\n\ts_nop 0\n\tglobal_load_lds_dwordx4 %1, off\n\ts_mov_b32 m0, %0":"=&s"(keep):"v"(gsrc),"s"(lds_dst):"memory");}
__device__ __forceinline__ float max3f(float a,float b,float c){float r;asm("v_max3_f32 %0, %1, %2, %3":"=v"(r):"v"(a),"v"(b),"v"(c));return r;}
__device__ __forceinline__ float max2f(float a,float b){float r;asm("v_max_f32_e32 %0, %1, %2":"=v"(r):"v"(a),"v"(b));return r;}
__device__ __forceinline__ float fadd_s(float a,float b){float r;asm("v_add_f32_e32 %0, %1, %2":"=v"(r):"v"(a),"v"(b));return r;}
__device__ __forceinline__ float fsub_s(float a,float b){float r;asm("v_sub_f32_e32 %0, %1, %2":"=v"(r):"v"(a),"v"(b));return r;}
typedef float f32x2_t __attribute__((ext_vector_type(2))); typedef __bf16 bf16x2_t __attribute__((ext_vector_type(2)));
__device__ __forceinline__ unsigned cvtpk_s(float lo,float hi){f32x2_t v={lo,hi};bf16x2_t b=__builtin_convertvector(v,bf16x2_t);return __builtin_bit_cast(unsigned,b);}
#define WAIT_BAR(N) asm volatile("s_waitcnt vmcnt(" #N ") lgkmcnt(0)\n\ts_barrier":::"memory")

__device__ __forceinline__ void qkt(f32x16&p0,f32x16&p1,const char*Kslot,const bf16x8*qr,const f32x16&negm,int r32,int hi){
  const char*kb=Kslot+hi*1024+r32*16;
  #pragma unroll
  for(int d0=0;d0<4;++d0){
    const bf16x8 b0=*reinterpret_cast<const bf16x8*>(kb+d0*2048);
    const bf16x8 b1=*reinterpret_cast<const bf16x8*>(kb+d0*2048+512);
    if(d0==0){p0=__builtin_amdgcn_mfma_f32_32x32x16_bf16(b0,qr[0],negm,0,0,0);p1=__builtin_amdgcn_mfma_f32_32x32x16_bf16(b1,qr[0],negm,0,0,0);}
    else{p0=__builtin_amdgcn_mfma_f32_32x32x16_bf16(b0,qr[d0],p0,0,0,0);p1=__builtin_amdgcn_mfma_f32_32x32x16_bf16(b1,qr[d0],p1,0,0,0);}}
}
typedef __attribute__((address_space(3))) const char* lds_cptr;
typedef short v4i16_t __attribute__((ext_vector_type(4)));
__device__ __forceinline__ void kload8(bf16x8*kf,lds_cptr kp){
  kf[0]=*(const __attribute__((address_space(3))) bf16x8*)(kp);      kf[1]=*(const __attribute__((address_space(3))) bf16x8*)(kp+512);
  kf[2]=*(const __attribute__((address_space(3))) bf16x8*)(kp+2048); kf[3]=*(const __attribute__((address_space(3))) bf16x8*)(kp+2560);
  kf[4]=*(const __attribute__((address_space(3))) bf16x8*)(kp+4096); kf[5]=*(const __attribute__((address_space(3))) bf16x8*)(kp+4608);
  kf[6]=*(const __attribute__((address_space(3))) bf16x8*)(kp+6144); kf[7]=*(const __attribute__((address_space(3))) bf16x8*)(kp+6656);
}
__device__ __forceinline__ void kload2(bf16x8*kf,lds_cptr kp,int j){ kf[2*j]=*(const __attribute__((address_space(3))) bf16x8*)(kp+j*2048); kf[2*j+1]=*(const __attribute__((address_space(3))) bf16x8*)(kp+j*2048+512); }
__device__ __forceinline__ s16x4 vtr(lds_cptr p){ return __builtin_bit_cast(s16x4,__builtin_amdgcn_ds_read_tr16_b64_v4i16((__attribute__((address_space(3))) v4i16_t*)p)); }
__device__ __forceinline__ float rowmax(const f32x16&p0,const f32x16&p1){
  float a=max3f(p0[0],p0[1],p1[0]),b=max3f(p0[2],p0[3],p1[1]);a=max3f(a,p1[2],p1[3]);
  #pragma unroll
  for(int r=4;r<16;r+=4){a=max3f(a,p0[r],p0[r+1]);b=max3f(b,p0[r+2],p0[r+3]);a=max3f(a,p1[r],p1[r+1]);b=max3f(b,p1[r+2],p1[r+3]);}
  const float m=max2f(a,b);
  auto rr=__builtin_amdgcn_permlane32_swap(__float_as_uint(m),__float_as_uint(m),false,false);
  return max2f(__uint_as_float(rr[0]),__uint_as_float(rr[1]));
}
__device__ __forceinline__ void pv(f32x16*o,int vb,bf16x8 pa0,bf16x8 pa1,bf16x8 pa2,bf16x8 pa3){
  #pragma unroll
  for(int d0=0;d0<4;++d0){s16x4 lo[4],hi[4];
    #pragma unroll
    for(int ks=0;ks<4;++ks){
      asm volatile("ds_read_b64_tr_b16 %0,%1 offset:%c2":"=&v"(lo[ks]):"v"(vb),"i"(d0*4096+ks*1024):"memory");
      asm volatile("ds_read_b64_tr_b16 %0,%1 offset:%c2":"=&v"(hi[ks]):"v"(vb),"i"(d0*4096+ks*1024+512):"memory");}
    asm volatile("s_waitcnt lgkmcnt(0)":::"memory");SBAR();
    #define PK(k) (bf16x8){lo[k][0],lo[k][1],lo[k][2],lo[k][3],hi[k][0],hi[k][1],hi[k][2],hi[k][3]}
    o[d0]=__builtin_amdgcn_mfma_f32_32x32x16_bf16(pa0,PK(0),o[d0],0,0,0);
    o[d0]=__builtin_amdgcn_mfma_f32_32x32x16_bf16(pa1,PK(1),o[d0],0,0,0);
    o[d0]=__builtin_amdgcn_mfma_f32_32x32x16_bf16(pa2,PK(2),o[d0],0,0,0);
    o[d0]=__builtin_amdgcn_mfma_f32_32x32x16_bf16(pa3,PK(3),o[d0],0,0,0);
    #undef PK
  }
}

template<int THRL> __device__ __forceinline__ void attn_pass(const bf16*Qw,const bf16*__restrict__ Kh,const bf16*__restrict__ Vh,int q0,char*shm,f32x16(&o)[4],float&l_reg){
  int tid_=threadIdx.x; asm volatile("":"+v"(tid_)); const int tid=tid_,lane=tid&63,r32=lane&31,hi=lane>>5; const int wid=__builtin_amdgcn_readfirstlane(tid>>6);
  const unsigned lds0=(unsigned)(uintptr_t)shm;
  float*wsf=(float*)(shm+LDS_WS)+wid*64;
  const bf16*ksrc=Kh+(long)lane*DM+wid*8;
  const bf16*vsrc=Vh+(long)(16*(wid&3)+(lane>>2))*DM+(wid>>2)*32+(lane&3)*8;
  const unsigned kdst=lds0+LDS_K+wid*1024, vdst=lds0+LDS_V+wid*1024;
  #define DMA_K(t,slot) glds16(ksrc+(long)(t)*KVBLK*DM,(unsigned)__builtin_amdgcn_readfirstlane(kdst+(slot)))
  #define DMA_V(t,vslot) do{ glds16(vsrc+(long)(t)*KVBLK*DM,(unsigned)__builtin_amdgcn_readfirstlane(vdst+(vslot))); glds16(vsrc+(long)(t)*KVBLK*DM+64,(unsigned)__builtin_amdgcn_readfirstlane(vdst+(vslot)+8192)); }while(0)
  const int vb0=(int)(lds0+LDS_V)+((lane>>4)&1)*32+(lane&3)*8+(4*hi+((lane&15)>>2))*64;
  const char*Kbase=shm+LDS_K; bf16x8 kf[8];
  const lds_cptr shm3=(lds_cptr)shm; const lds_cptr kp0=shm3+LDS_K+hi*1024+r32*16; const lds_cptr vp0=shm3+LDS_V+((lane>>4)&1)*32+(lane&3)*8+(4*hi+((lane&15)>>2))*64;
  const int NT=(q0+QB)/KVBLK;
  DMA_K(0,0);DMA_V(0,0);DMA_K(1,SLOTB);
  bf16x8 qr[4];
  #pragma unroll
  for(int d0=0;d0<4;++d0)qr[d0]=*reinterpret_cast<const bf16x8*>(&Qw[(long)r32*DM+d0*16+hi*8]);
  float mhat=0.f;l_reg=0.f;o[0]=f32x16{};o[1]=f32x16{};o[2]=f32x16{};o[3]=f32x16{};f32x16 negm=f32x16{};asm volatile("":"+v"(negm));
  const int qrel=wid*QBLK+r32;
  #define CMASK(P0,P1,t) do{int jb_=(t)-(NT-4); if(jb_>=0)cmask(P0,P1,jb_,qrel,hi);}while(0)
  bool resc=false;
  #define START(P0,P1) do{ const float rm=rowmax(P0,P1); resc=false; \
    { const float dl=rm; mhat=fadd_s(mhat,dl); \
      _Pragma("unroll") for(int r=0;r<16;++r){P0[r]=fsub_s(P0[r],dl);P1[r]=fsub_s(P1[r],dl);} \
      _Pragma("unroll") for(int r=0;r<16;++r)negm[r]=-mhat; asm volatile("":"+v"(negm)); } \
    _Pragma("unroll") for(int r=0;r<16;++r)P0[r]=__builtin_amdgcn_exp2f(P0[r]); }while(0)
  #define RESC() do{ if(resc){ asm volatile("s_waitcnt lgkmcnt(0)":::"memory"); \
      _Pragma("unroll") for(int d_=0;d_<4;++d_) _Pragma("unroll") for(int r=0;r<16;++r)o[d_][r]*=wsf[crow(r,hi)]; } }while(0)
  f32x16 pA0,pA1,pB0,pB1;
  int sl_prev=0,sl_cur=0,sl_next=SLOTB;
  #define ROT() do{sl_prev=sl_cur;sl_cur=sl_next;sl_next=(sl_next==(NSLOT-1)*SLOTB)?0:sl_next+SLOTB;}while(0)
  DMA_K(2,2*SLOTB);
  WAIT_BAR(4);
  qkt(pA0,pA1,Kbase,qr,negm,r32,hi);asm volatile("s_nop 15\n\ts_nop 7":"+v"(pA0),"+v"(pA1));CMASK(pA0,pA1,0);
  START(pA0,pA1);
  _Pragma("unroll") for(int r=0;r<16;++r)pA1[r]=__builtin_amdgcn_exp2f(pA1[r]);
  WAIT_BAR(0);
  DMA_K(3,0);DMA_V(1,2*SLOTB);
  ROT();
  kload8(kf,kp0+sl_cur);
  WAIT_BAR(3);
  s16x4 vlo[8],vhi[8]; u32x4 pw0,pw1,pw2,pw3;
  #define PKW(P,B) cvtpk_s(P[B],P[B+1])
  #define PAF(k) __builtin_bit_cast(bf16x8,pw##k)
  #define VFR(i) (bf16x8){vlo[i][0],vlo[i][1],vlo[i][2],vlo[i][3],vhi[i][0],vhi[i][1],vhi[i][2],vhi[i][3]}
  #define PIN(x) asm volatile("":"+v"(x))
  #define MX3(a,b,c) __builtin_fmaxf(__builtin_fmaxf((a),(b)),(c))
  #define GAPA(MF,A0,A1,A2,A3,W0,W1,PW) do{ MF; sacc+=A0; sacc+=A1; sacc+=A2; sacc+=A3; PIN(sacc); W0; W1; PIN(PW); SBAR(); }while(0)
  #define EX(v) __builtin_amdgcn_exp2f(v)
  #define GAPB(MF,X,B) do{ MF; X[B]=EX(X[B]); X[B+1]=EX(X[B+1]); PIN(X); SBAR(); }while(0)
  #define VRD2(i) do{ vlo[i]=vtr(vp_+((2+((i)>>2))*4096+((i)&3)*1024)); vhi[i]=vtr(vp_+((2+((i)>>2))*4096+((i)&3)*1024+512)); SBAR(); }while(0)
  #define VRD(i) do{ vlo[i]=vtr(vp_+(((i)>>2)*4096+((i)&3)*1024)); vhi[i]=vtr(vp_+(((i)>>2)*4096+((i)&3)*1024+512)); }while(0)
  #define KRD(G,j) do{ if(G){ kload2(kf,kp0+sl_next,j); SBAR(); } }while(0)
  #define STEP(C0,C1,P0,P1,t,GK,GV,GL) do{ SBAR(); \
    const lds_cptr vp_=vp0+2*sl_prev; \
    VRD(0); SBAR(); float sacc=(P0[0]+P0[1]); \
    GAPA(C0=__builtin_amdgcn_mfma_f32_32x32x16_bf16(kf[0],qr[0],negm,0,0,0), P0[2],P0[3],P0[4],P0[5],     pw0[0]=PKW(P0,0), pw0[1]=PKW(P0,2), pw0); \
    VRD(4); SBAR(); GAPA(C1=__builtin_amdgcn_mfma_f32_32x32x16_bf16(kf[1],qr[0],negm,0,0,0), P0[6],P0[7],P0[8],P0[9],     pw0[2]=PKW(P0,4), pw0[3]=PKW(P0,6), pw0); \
    VRD(1); SBAR(); GAPA(C0=__builtin_amdgcn_mfma_f32_32x32x16_bf16(kf[2],qr[1],C0,0,0,0),   P0[10],P0[11],P0[12],P0[13], pw1[0]=PKW(P0,8), pw1[1]=PKW(P0,10), pw1); \
    VRD(5); SBAR(); GAPA(C1=__builtin_amdgcn_mfma_f32_32x32x16_bf16(kf[3],qr[1],C1,0,0,0),   P0[14],P0[15],P1[0],P1[1],   pw1[2]=PKW(P0,12),pw1[3]=PKW(P0,14), pw1); \
    VRD(2); SBAR(); GAPA(C0=__builtin_amdgcn_mfma_f32_32x32x16_bf16(kf[4],qr[2],C0,0,0,0),   P1[2],P1[3],P1[4],P1[5],     pw2[0]=PKW(P1,0), pw2[1]=PKW(P1,2), pw2); \
    VRD(6); SBAR(); GAPA(C1=__builtin_amdgcn_mfma_f32_32x32x16_bf16(kf[5],qr[2],C1,0,0,0),   P1[6],P1[7],P1[8],P1[9],     pw2[2]=PKW(P1,4), pw2[3]=PKW(P1,6), pw2); \
    VRD(3); SBAR(); GAPA(C0=__builtin_amdgcn_mfma_f32_32x32x16_bf16(kf[6],qr[3],C0,0,0,0),   P1[10],P1[11],P1[12],P1[13], pw3[0]=PKW(P1,8), pw3[1]=PKW(P1,10), pw3); \
    VRD(7); SBAR(); GAPA(C1=__builtin_amdgcn_mfma_f32_32x32x16_bf16(kf[7],qr[3],C1,0,0,0),   P1[14],P1[15],0.f,0.f,       pw3[2]=PKW(P1,12),pw3[3]=PKW(P1,14), pw3); \
    l_reg+=sacc; \
    if(GK){DMA_K((t)+3,sl_cur);} if(GV){DMA_V((t)+1,2*sl_next);} \
    CMASK(C0,C1,t); \
    { float a=MX3(C0[0],C0[1],C1[0]),b=MX3(C0[2],C0[3],C1[1]); a=MX3(a,C1[2],C1[3]); \
      _Pragma("unroll") for(int r=4;r<16;r+=4){a=MX3(a,C0[r],C0[r+1]);b=MX3(b,C0[r+2],C0[r+3]);a=MX3(a,C1[r],C1[r+1]);b=MX3(b,C1[r+2],C1[r+3]);} \
      float rm=__builtin_fmaxf(a,b); { auto rr=__builtin_amdgcn_permlane32_swap(__float_as_uint(rm),__float_as_uint(rm),false,false); rm=__builtin_fmaxf(__uint_as_float(rr[0]),__uint_as_float(rr[1])); } \
      resc=false; \
      if(__builtin_expect(__any(rm>(float)THRL),0)){ const float dl=__builtin_fmaxf(rm,0.f); mhat+=dl; \
        _Pragma("unroll") for(int r=0;r<16;++r){C0[r]-=dl;C1[r]-=dl;} \
        _Pragma("unroll") for(int r=0;r<16;++r)negm[r]=-mhat; asm volatile("":"+v"(negm)); \
        const float f=__builtin_amdgcn_exp2f(-dl); l_reg*=f; if(hi==0)wsf[r32]=f; resc=true; } } \
    SBAR(); \
    GAPB(o[0]=__builtin_amdgcn_mfma_f32_32x32x16_bf16(PAF(0),VFR(0),o[0],0,0,0), C0,0);  VRD2(0); \
    GAPB(o[1]=__builtin_amdgcn_mfma_f32_32x32x16_bf16(PAF(0),VFR(4),o[1],0,0,0), C0,2);  VRD2(4); \
    KRD(GL,0); GAPB(o[0]=__builtin_amdgcn_mfma_f32_32x32x16_bf16(PAF(1),VFR(1),o[0],0,0,0), C0,4);  VRD2(1); \
    KRD(GL,1); GAPB(o[1]=__builtin_amdgcn_mfma_f32_32x32x16_bf16(PAF(1),VFR(5),o[1],0,0,0), C0,6);  VRD2(5); \
    KRD(GL,2); GAPB(o[0]=__builtin_amdgcn_mfma_f32_32x32x16_bf16(PAF(2),VFR(2),o[0],0,0,0), C0,8);  VRD2(2); \
    KRD(GL,3); GAPB(o[1]=__builtin_amdgcn_mfma_f32_32x32x16_bf16(PAF(2),VFR(6),o[1],0,0,0), C0,10); VRD2(6); \
    GAPB(o[0]=__builtin_amdgcn_mfma_f32_32x32x16_bf16(PAF(3),VFR(3),o[0],0,0,0), C0,12); VRD2(3); \
    GAPB(o[1]=__builtin_amdgcn_mfma_f32_32x32x16_bf16(PAF(3),VFR(7),o[1],0,0,0), C0,14); VRD2(7); \
    GAPB(o[2]=__builtin_amdgcn_mfma_f32_32x32x16_bf16(PAF(0),VFR(0),o[2],0,0,0), C1,0); \
    GAPB(o[3]=__builtin_amdgcn_mfma_f32_32x32x16_bf16(PAF(0),VFR(4),o[3],0,0,0), C1,2); \
    GAPB(o[2]=__builtin_amdgcn_mfma_f32_32x32x16_bf16(PAF(1),VFR(1),o[2],0,0,0), C1,4); \
    GAPB(o[3]=__builtin_amdgcn_mfma_f32_32x32x16_bf16(PAF(1),VFR(5),o[3],0,0,0), C1,6); \
    GAPB(o[2]=__builtin_amdgcn_mfma_f32_32x32x16_bf16(PAF(2),VFR(2),o[2],0,0,0), C1,8); \
    GAPB(o[3]=__builtin_amdgcn_mfma_f32_32x32x16_bf16(PAF(2),VFR(6),o[3],0,0,0), C1,10); \
    GAPB(o[2]=__builtin_amdgcn_mfma_f32_32x32x16_bf16(PAF(3),VFR(3),o[2],0,0,0), C1,12); \
    GAPB(o[3]=__builtin_amdgcn_mfma_f32_32x32x16_bf16(PAF(3),VFR(7),o[3],0,0,0), C1,14); \
    }while(0)
  int t=1;
  #undef CMASK
  #define CMASK(P0,P1,t) do{}while(0)
  for(;t+5<NT;t+=2){
    STEP(pB0,pB1,pA0,pA1,t,true,true,true);     WAIT_BAR(3); RESC(); ROT();
    STEP(pA0,pA1,pB0,pB1,t+1,true,true,true);   WAIT_BAR(3); RESC(); ROT();
  }
  #undef CMASK
  #define CMASK(P0,P1,t) do{int jb_=(t)-(NT-4); if(jb_>=0)cmask(P0,P1,jb_,qrel,hi);}while(0)
  #define ENDW(tt) do{ if((tt)+3<NT){WAIT_BAR(3);} else if((tt)+2<NT){WAIT_BAR(2);} else {WAIT_BAR(0);} }while(0)
  for(;t+1<NT;t+=2){
    STEP(pB0,pB1,pA0,pA1,t,(t+3<NT),(t+1<NT),(t+1<NT));       ENDW(t);   RESC(); ROT();
    STEP(pA0,pA1,pB0,pB1,t+1,(t+4<NT),(t+2<NT),(t+2<NT));     ENDW(t+1); RESC(); ROT();
  }
  STEP(pB0,pB1,pA0,pA1,NT-1,false,false,false); RESC();
  { float sacc=pB0[0]+pB0[1]; _Pragma("unroll") for(int r=2;r<16;++r)sacc+=pB0[r]; _Pragma("unroll") for(int r=0;r<16;++r)sacc+=pB1[r]; l_reg+=sacc;
    pw0=(u32x4){PKW(pB0,0),PKW(pB0,2),PKW(pB0,4),PKW(pB0,6)};pw1=(u32x4){PKW(pB0,8),PKW(pB0,10),PKW(pB0,12),PKW(pB0,14)};pw2=(u32x4){PKW(pB1,0),PKW(pB1,2),PKW(pB1,4),PKW(pB1,6)};pw3=(u32x4){PKW(pB1,8),PKW(pB1,10),PKW(pB1,12),PKW(pB1,14)};
    SBAR(); pv(o,vb0+2*sl_cur,PAF(0),PAF(1),PAF(2),PAF(3)); }
  #undef PKW
  #undef PAF
  #undef VFR
  #undef PIN
  #undef MX3
  #undef GAPA
  #undef GAPB
  #undef EX
  #undef VRD
  #undef VRD2
  #undef KRD
  #undef STEP
  #undef ENDW
  asm volatile("s_waitcnt lgkmcnt(0)\n\ts_barrier":::"memory");
  #undef DMA_K
  #undef DMA_V
  #undef CMASK
  #undef START
  #undef RESC
  #undef ROT
}
constexpr int ZQA_=2048, ZKA_=2560, ZVA_=3072, MIXP=1024;
struct DiffParams { const bf16* Z; bf16* MIX; const float* g; float lam; float oscale; };
template<int THRL> __device__ __forceinline__ void diffattn_unit(int b,int h,int qb,const DiffParams&P,char*shm){
  const long rowbase=(long)b*SEQ; const int q0=qb*QB;
  #pragma unroll 1
  for(int c=0;c<2;++c){
    f32x16 o[4]; float l_reg;
    { const int wid0=__builtin_amdgcn_readfirstlane((int)threadIdx.x>>6);
      const bf16*Qw=P.Z+(rowbase+q0+wid0*QBLK)*DM+ZQA_+h*128+c*64;
      const bf16*Kh=P.Z+rowbase*DM+ZKA_+h*128+c*64; const bf16*Vh=P.Z+rowbase*DM+ZVA_+h*128;
      attn_pass<THRL>(Qw,Kh,Vh,q0,shm,o,l_reg); }
    int tid=threadIdx.x; asm volatile("":"+v"(tid));
    const int lane=tid&63,r32=lane&31,hi=lane>>5; const int wid=__builtin_amdgcn_readfirstlane(tid>>6);
    float*wsf=(float*)(shm+LDS_WS)+wid*64;
    unsigned*stA=(unsigned*)(shm+LDS_ST+wid*8192)+lane;
    {auto rr=__builtin_amdgcn_permlane32_swap(__float_as_uint(l_reg),__float_as_uint(l_reg),false,false);l_reg=__uint_as_float(rr[0])+__uint_as_float(rr[1]);}
    if(hi==0)wsf[32+r32]=l_reg;asm volatile("s_waitcnt lgkmcnt(0)":::"memory");
    #pragma unroll
    for(int r=0;r<16;++r){const float rl=__builtin_amdgcn_rcpf(wsf[32+crow(r,hi)]);o[0][r]*=rl;o[1][r]*=rl;o[2][r]*=rl;o[3][r]*=rl;}
    if(c==0){
      #pragma unroll
      for(int k=0;k<32;++k)stA[k*64]=cvtpk_s(o[k>>3][2*(k&7)],o[k>>3][2*(k&7)+1]);
    }else{
      #pragma unroll
      for(int k=0;k<32;++k){const unsigned a=stA[k*64];
        o[k>>3][2*(k&7)]=__uint_as_float(a<<16)-P.lam*o[k>>3][2*(k&7)];
        o[k>>3][2*(k&7)+1]=__uint_as_float(a&0xffff0000u)-P.lam*o[k>>3][2*(k&7)+1];}
      float ss[16];
      #pragma unroll
      for(int r=0;r<16;++r)ss[r]=(o[0][r]*o[0][r]+o[1][r]*o[1][r])+(o[2][r]*o[2][r]+o[3][r]*o[3][r]);
      { const bool b4=(lane&16)!=0,b3=(lane&8)!=0,b2=(lane&4)!=0,b1=(lane&2)!=0;
        float t8[8],t4[4],t2[2],t1;
        #pragma unroll
        for(int i=0;i<8;++i){const float keep=b4?ss[i+8]:ss[i],send=b4?ss[i]:ss[i+8];t8[i]=keep+__shfl_xor(send,16);}
        #pragma unroll
        for(int i=0;i<4;++i){const float keep=b3?t8[i+4]:t8[i],send=b3?t8[i]:t8[i+4];t4[i]=keep+__shfl_xor(send,8);}
        #pragma unroll
        for(int i=0;i<2;++i){const float keep=b2?t4[i+2]:t4[i],send=b2?t4[i]:t4[i+2];t2[i]=keep+__shfl_xor(send,4);}
        {const float keep=b1?t2[1]:t2[0],send=b1?t2[0]:t2[1];t1=keep+__shfl_xor(send,2);}
        t1+=__shfl_xor(t1,1);
        if((lane&1)==0)wsf[hi*16+((lane>>1)&15)]=__builtin_amdgcn_rsqf(t1*(1.0f/128.0f)+1e-5f)*P.oscale; }
      asm volatile("s_waitcnt lgkmcnt(0)":::"memory");
      const float g0=P.g[h*128+r32],g1=P.g[h*128+32+r32],g2=P.g[h*128+64+r32],g3=P.g[h*128+96+r32];
      bf16*st=(bf16*)(shm+LDS_ST+wid*8192);
      #pragma unroll
      for(int r=0;r<16;++r){const float rs=wsf[hi*16+r];const int orow=crow(r,hi);
        st[orow*128+r32]=__float2bfloat16(o[0][r]*rs*g0); st[orow*128+32+r32]=__float2bfloat16(o[1][r]*rs*g1);
        st[orow*128+64+r32]=__float2bfloat16(o[2][r]*rs*g2); st[orow*128+96+r32]=__float2bfloat16(o[3][r]*rs*g3);}
      asm volatile("s_waitcnt lgkmcnt(0)":::"memory");
      bf16*mo=P.MIX+(rowbase+q0+wid*QBLK)*MIXP+512+h*128;
      #pragma unroll
      for(int i=0;i<8;++i){const int row=i*4+(lane>>4),ch=lane&15;
        const u32x4 v=*(const u32x4*)(st+row*128+ch*8); *(u32x4*)(mo+(long)row*MIXP+ch*8)=v;}
    }
  }
}
template<int THRL=8> __device__ __forceinline__ void diffattn_queue(char*lds,const DiffParams&P,unsigned*qctr,volatile __attribute__((address_space(3))) unsigned*slot){
  const int j=(int)blockIdx.x&7;
  for(;;){
    __syncthreads();
    if(threadIdx.x==0)*slot=__hip_atomic_fetch_add(qctr+64*j,1u,__ATOMIC_RELAXED,__HIP_MEMORY_SCOPE_AGENT);
    __syncthreads();
    const unsigned v=(unsigned)__builtin_amdgcn_readfirstlane((int)*slot);
    if(v>=64u)break;
#if ATTN_ORDER == 0
    const int bh=8*j+(int)(v>>3),qb=7-(int)(v&7u);
#elif ATTN_ORDER == 1
    const int bh=8*j+(int)(v&7u),qb=7-(int)(v>>3);
#elif ATTN_ORDER == 2
    const int bh=8*j+4*(int)(v>>5)+(int)(v&3u),qb=7-(int)((v&31u)>>2);
#else
    const int bh=8*j+2*(int)(v>>4)+(int)(v&1u),qb=7-(int)((v&15u)>>1);
#endif
    diffattn_unit<THRL>(bh>>2,bh&3,qb,P,lds);
  }
}
constexpr int ATTN_LDS_BYTES=LDS_BYTES;
#undef SBAR
#undef WAIT_BAR
}
namespace mls {
#define MLAS __attribute__((address_space(3)))
typedef short bf16x8 __attribute__((ext_vector_type(8)));
typedef float f32x4 __attribute__((ext_vector_type(4)));
typedef unsigned u32x4 __attribute__((ext_vector_type(4)));
typedef unsigned u32x2 __attribute__((ext_vector_type(2)));
constexpr int SEQ = 2048, ZP = 3584, ZQM = 0, ZKM = 512, ZVM = 1024, ZOM = 1536, MIXP = 1024;
constexpr int PQ = 136, PT = 72, PV = 152, PH = 132;
constexpr int O_QS = 0, O_KS = 17408, O_HS = 0, O_KW = 34816, O_VS = 52224, O_SC = 71680, O_CB = 80896, O_SCAL = 120064, O_CW = 121088, O_CH = 126208, O_GM = 126720, O_HB = 127232, O_DEN = 144640, O_SCAL2 = 144896, LDS_BYTES = 145920;
static_assert(O_KS == 64 * PQ * 2 && O_KW == 2 * 64 * PQ * 2 && O_VS == O_KW + 64 * PQ * 2 && O_SC == O_VS + 64 * PV * 2 && O_CB == O_SC + 64 * PT * 2 && O_SCAL == O_CB + 144 * PQ * 2 && O_CW == O_SCAL + 1024 && O_CH == O_CW + 5120 && O_GM == O_CH + 512 && O_HB == O_GM + 512 && O_DEN == O_HB + 64 * PQ * 2 && O_SCAL2 == O_DEN + 256 && LDS_BYTES == O_SCAL2 + 1024, "mLSTM LDS map");
struct Params { const unsigned short* Z; const unsigned short* QC  ; unsigned short* MIX; float* scal  ; const float* cht  ; const float* gates; const float* conv_w; const float* conv_b; const float* b_gates; const float* g_mh; };
typedef float f32x2_t __attribute__((ext_vector_type(2))); typedef __bf16 bf16x2_t __attribute__((ext_vector_type(2)));
__device__ __forceinline__ unsigned cvt2(float lo, float hi) { f32x2_t v = {lo, hi}; bf16x2_t b = __builtin_convertvector(v, bf16x2_t); return __builtin_bit_cast(unsigned, b); }
__device__ __forceinline__ void unpk8(const u32x4& w, float* f) {
    f[0] = __uint_as_float(w.x << 16); f[1] = __uint_as_float(w.x & 0xffff0000u); f[2] = __uint_as_float(w.y << 16); f[3] = __uint_as_float(w.y & 0xffff0000u);
    f[4] = __uint_as_float(w.z << 16); f[5] = __uint_as_float(w.z & 0xffff0000u); f[6] = __uint_as_float(w.w << 16); f[7] = __uint_as_float(w.w & 0xffff0000u);
}
__device__ __forceinline__ float scan_add(float v, int lane) {
#pragma unroll
    for (int d = 1; d < 64; d <<= 1) { const float t = __shfl_up(v, d); if (lane >= d) v += t; }
    return v;
}
__device__ __forceinline__ float scan_max(float v, int lane) {
#pragma unroll
    for (int d = 1; d < 64; d <<= 1) { const float t = __shfl_up(v, d); if (lane >= d) v = fmaxf(v, t); }
    return v;
}
__device__ __forceinline__ float wave_max(float v) {
#pragma unroll
    for (int o = 1; o < 64; o <<= 1) v = fmaxf(v, __shfl_xor(v, o));
    return v;
}
__device__ __forceinline__ float wave_add(float v) {
#pragma unroll
    for (int o = 1; o < 64; o <<= 1) v += __shfl_xor(v, o);
    return v;
}
#define MFMA16(a, b, c) __builtin_amdgcn_mfma_f32_16x16x32_bf16(a, b, c, 0, 0, 0)
#define LDFRAG(off) (*(const MLAS bf16x8*)(lds + (off)))
typedef short v4i16_t __attribute__((ext_vector_type(4)));
__device__ __forceinline__ bf16x8 trfrag(MLAS unsigned char* lds, int off, int pitch, int fr, int g) {
    MLAS unsigned char* p = lds + off + ((8 * g + (fr >> 2)) * pitch + 4 * (fr & 3)) * 2;
    const v4i16_t a = __builtin_amdgcn_ds_read_tr16_b64_v4i16((MLAS v4i16_t*)p), b = __builtin_amdgcn_ds_read_tr16_b64_v4i16((MLAS v4i16_t*)(p + 4 * pitch * 2));
    return (bf16x8){a[0], a[1], a[2], a[3], b[0], b[1], b[2], b[3]};
}

template <int VAR> __device__ __forceinline__ void unit(const Params& P, int b, int h, MLAS unsigned char* lds, const int c_begin, const int c_end) {
    int tid_ = threadIdx.x; asm volatile("" : "+v"(tid_));
    const int tid = tid_, lane0 = tid & 63, wave = __builtin_amdgcn_readfirstlane(tid >> 6);
#define MLS_LANE() int lane_ = lane0; asm volatile("" : "+v"(lane_)); const int lane = lane_, fr = lane & 15, g = lane >> 4; (void)fr; (void)g
    const size_t seq0 = (size_t)b * SEQ;
    for (int i = tid; i < 144 * PQ / 2; i += 512) ((MLAS unsigned*)(lds + O_CB))[i] = 0u;
    if (tid < 128) ((MLAS float*)(lds + O_GM))[tid] = P.g_mh[h * 128 + tid];
    for (int i = tid; i < 64 * 12; i += 512) { const int r = i / 12, c = i % 12; ((MLAS unsigned*)(lds + O_VS + (r * PV + 128) * 2))[c] = (c == 0) ? 0x00003f80u : 0u; }
    for (int i = tid; i < 2 * 5 * 128; i += 512) { const int qk = i / 640, tap = (i / 128) % 5, d = i & 127;
        ((MLAS float*)(lds + O_CW))[i] = (tap < 4) ? P.conv_w[tap * 1024 + qk * 512 + h * 128 + d] : P.conv_b[qk * 512 + h * 128 + d]; }
    f32x4 cacc[9];
#pragma unroll
    for (int eb = 0; eb < 9; ++eb) cacc[eb] = (f32x4){0.f, 0.f, 0.f, 0.f};
    const float kscale = 0.08838834764831845f;
    float* scalb = P.scal;
    { MLS_LANE(); MLAS float* chp = (MLAS float*)(lds + O_CH); const float bi = P.b_gates[h], bfg = P.b_gates[4 + h];
#pragma unroll 1
      for (int cc = 0; cc < 4; ++cc) { const int c = 4 * wave + cc; const size_t row = seq0 + 64 * c + lane;
          const float gi = P.gates[row * 8 + h] + bi, gf = P.gates[row * 8 + 4 + h] + bfg;
          const float lf = fminf(gf, 0.f) - log1pf(__expf(-fabsf(gf)));
          const float bc = scan_add(lf, lane); const float u = gi - bc; const float amax = scan_max(u, lane);
          *(f32x4*)(scalb + (size_t)(64 * c + lane) * 4) = (f32x4){u, bc, amax, 0.f};
          const float blast = __shfl(bc, 63), gmax = blast + __shfl(amax, 63);
          if (lane == 0) { chp[c] = blast; chp[32 + c] = gmax; } } }
    asm volatile("s_waitcnt vmcnt(0)" ::: "memory");
    __syncthreads();
    if (tid == 0) { MLAS float* chp = (MLAS float*)(lds + O_CH); float m = 0.f;
#pragma unroll 1
        for (int c = 0; c < 32; ++c) { chp[64 + c] = m; m = fmaxf(chp[c] + m, chp[32 + c]); }
        chp[96] = m; }
    u32x4 qrow[5], krow[5], vrow[2], ograw[2]; f32x4 sc_own; float u_r0, u_r1;
#define MLS_LOAD_RAW(ch) do { const int t0_ = (ch) * 64, p_ = 4 * wave + (lane >> 4), d8_ = lane & 15; \
        _Pragma("unroll") for (int j_ = 0; j_ < 5; ++j_) { int tt_ = t0_ + 2 * p_ - 3 + j_; tt_ = tt_ < 0 ? 0 : tt_; const unsigned short* zr_ = P.Z + (seq0 + tt_) * ZP + h * 128 + 8 * d8_; \
            qrow[j_] = *(const u32x4*)(zr_ + ZQM); krow[j_] = *(const u32x4*)(zr_ + ZKM); if (j_ >= 3) vrow[j_ - 3] = *(const u32x4*)(zr_ + ZVM); } \
        _Pragma("unroll") for (int it_ = 0; it_ < 2; ++it_) ograw[it_] = *(const u32x4*)(P.Z + (seq0 + t0_ + wave * 8 + 4 * it_ + (lane >> 4)) * ZP + ZOM + h * 128 + 8 * (lane & 15)); \
        sc_own = *(const f32x4*)(scalb + (size_t)(t0_ + lane) * 4); u_r0 = scalb[(size_t)(t0_ + 2 * p_) * 4]; u_r1 = scalb[(size_t)(t0_ + 2 * p_ + 1) * 4]; } while (0)
#define MLS_LOAD_KV(ch) do { const int t0_ = (ch) * 64, p_ = 4 * wave + (lane >> 4), d8_ = lane & 15; \
        _Pragma("unroll") for (int j_ = 0; j_ < 5; ++j_) { int tt_ = t0_ + 2 * p_ - 3 + j_; tt_ = tt_ < 0 ? 0 : tt_; const unsigned short* zr_ = P.Z + (seq0 + tt_) * ZP + h * 128 + 8 * d8_; \
            krow[j_] = *(const u32x4*)(zr_ + ZKM); if (j_ >= 3) vrow[j_ - 3] = *(const u32x4*)(zr_ + ZVM); } \
        u_r0 = scalb[(size_t)(t0_ + 2 * p_) * 4]; u_r1 = scalb[(size_t)(t0_ + 2 * p_ + 1) * 4]; } while (0)
    __syncthreads();
    { MLS_LANE(); if (c_begin > 0) { MLS_LOAD_KV(0); qrow[0] = qrow[1] = qrow[2] = qrow[3] = qrow[4] = ograw[0] = ograw[1] = krow[0]; sc_own = (f32x4){0.f, 0.f, 0.f, 0.f}; } else MLS_LOAD_RAW(0); }
    if (VAR & 1) { _Pragma("unroll") for (int j = 0; j < 5; ++j) { qrow[j] = (u32x4){0x3f803f80u, 0x3f803f80u, 0x3f803f80u, 0x3f803f80u}; krow[j] = qrow[j]; } vrow[0] = qrow[0]; vrow[1] = qrow[0]; }
#pragma unroll 1
    for (int ch = 0; ch < c_end; ++ch) {
        const int t0 = ch * 64; const bool full = ch >= c_begin;
        float decay, mstc;
        u32x4 og[2];
        { MLS_LANE();
        og[0] = ograw[0]; og[1] = ograw[1];
        const MLAS float* chp = (const MLAS float*)(lds + O_CH);
        mstc = chp[64 + ch]; const float mnew = chp[65 + ch], blast = chp[ch];
        decay = __expf(blast + mstc - mnew);
        const float ws0 = __expf(blast + u_r0 - mnew), ws1 = __expf(blast + u_r1 - mnew);
        if (full && wave == 0) { MLAS float* sc = (MLAS float*)(lds + ((ch & 1) ? O_SCAL2 : O_SCAL)); sc[lane] = sc_own[0]; sc[64 + lane] = sc_own[1]; sc[128 + lane] = fmaxf(mstc, sc_own[2]); }
        if (!(VAR & 4)) {
        const int p = 4 * wave + (lane >> 4), d8 = lane & 15;
        float k0[8], k1[8];
        { const MLAS f32x4* cw = (const MLAS f32x4*)(lds + O_CW) + 2 * d8;
#define MLS_CONV(QK, RAW, O0, O1) do { { const f32x4 ba_ = cw[((QK) * 5 + 4) * 32], bb_ = cw[((QK) * 5 + 4) * 32 + 1]; \
              _Pragma("unroll") for (int x_ = 0; x_ < 4; ++x_) { O0[x_] = ba_[x_]; O1[x_] = ba_[x_]; O0[4 + x_] = bb_[x_]; O1[4 + x_] = bb_[x_]; } } \
            f32x4 pa_ = (f32x4){0.f, 0.f, 0.f, 0.f}, pb_ = pa_; \
            _Pragma("unroll") for (int j_ = 0; j_ < 5; ++j_) { float f_[8]; unpk8(RAW[j_], f_); \
                if (ch == 0 && j_ < 3) { const bool ok_ = (2 * p - 3 + j_) >= 0; _Pragma("unroll") for (int x_ = 0; x_ < 8; ++x_) f_[x_] = ok_ ? f_[x_] : 0.f; } \
                f32x4 wa_ = pa_, wb_ = pb_; if (j_ < 4) { wa_ = cw[((QK) * 5 + j_) * 32]; wb_ = cw[((QK) * 5 + j_) * 32 + 1]; \
                    _Pragma("unroll") for (int x_ = 0; x_ < 4; ++x_) { O0[x_] += f_[x_] * wa_[x_]; O0[4 + x_] += f_[4 + x_] * wb_[x_]; } } \
                if (j_ >= 1) { _Pragma("unroll") for (int x_ = 0; x_ < 4; ++x_) { O1[x_] += f_[x_] * pa_[x_]; O1[4 + x_] += f_[4 + x_] * pb_[x_]; } } \
                pa_ = wa_; pb_ = wb_; } } while (0)
          MLS_CONV(1, krow, k0, k1);
#pragma unroll
          for (int j = 0; j < 8; ++j) { k0[j] = k0[j] * __builtin_amdgcn_rcpf(1.0f + __expf(-k0[j])) * kscale; k1[j] = k1[j] * __builtin_amdgcn_rcpf(1.0f + __expf(-k1[j])) * kscale; }
          if (full) {
          float q0[8], q1[8];
          MLS_CONV(0, qrow, q0, q1);
#pragma unroll
          for (int j = 0; j < 8; ++j) { q0[j] = q0[j] * __builtin_amdgcn_rcpf(1.0f + __expf(-q0[j])); q1[j] = q1[j] * __builtin_amdgcn_rcpf(1.0f + __expf(-q1[j])); }
          u32x4 wq; wq.x = cvt2(q0[0], q0[1]); wq.y = cvt2(q0[2], q0[3]); wq.z = cvt2(q0[4], q0[5]); wq.w = cvt2(q0[6], q0[7]);
          *(MLAS u32x4*)(lds + O_QS + ((2 * p) * PQ + 8 * d8) * 2) = wq;
          wq.x = cvt2(q1[0], q1[1]); wq.y = cvt2(q1[2], q1[3]); wq.z = cvt2(q1[4], q1[5]); wq.w = cvt2(q1[6], q1[7]);
          *(MLAS u32x4*)(lds + O_QS + ((2 * p + 1) * PQ + 8 * d8) * 2) = wq;
          wq.x = cvt2(k0[0], k0[1]); wq.y = cvt2(k0[2], k0[3]); wq.z = cvt2(k0[4], k0[5]); wq.w = cvt2(k0[6], k0[7]);
          *(MLAS u32x4*)(lds + O_KS + ((2 * p) * PQ + 8 * d8) * 2) = wq;
          wq.x = cvt2(k1[0], k1[1]); wq.y = cvt2(k1[2], k1[3]); wq.z = cvt2(k1[4], k1[5]); wq.w = cvt2(k1[6], k1[7]);
          *(MLAS u32x4*)(lds + O_KS + ((2 * p + 1) * PQ + 8 * d8) * 2) = wq;
          }
#undef MLS_CONV
#pragma unroll
          for (int j = 0; j < 8; j += 2) { const unsigned a_ = cvt2(k0[j], k0[j + 1]), b_ = cvt2(k1[j], k1[j + 1]); k0[j] = __uint_as_float(a_ << 16); k0[j + 1] = __uint_as_float(a_ & 0xffff0000u); k1[j] = __uint_as_float(b_ << 16); k1[j + 1] = __uint_as_float(b_ & 0xffff0000u); }
        }
        u32x4 w; w.x = cvt2(k0[0] * ws0, k0[1] * ws0); w.y = cvt2(k0[2] * ws0, k0[3] * ws0); w.z = cvt2(k0[4] * ws0, k0[5] * ws0); w.w = cvt2(k0[6] * ws0, k0[7] * ws0);
        *(MLAS u32x4*)(lds + O_KW + ((2 * p) * PQ + 8 * d8) * 2) = w;
        w.x = cvt2(k1[0] * ws1, k1[1] * ws1); w.y = cvt2(k1[2] * ws1, k1[3] * ws1); w.z = cvt2(k1[4] * ws1, k1[5] * ws1); w.w = cvt2(k1[6] * ws1, k1[7] * ws1);
        *(MLAS u32x4*)(lds + O_KW + ((2 * p + 1) * PQ + 8 * d8) * 2) = w;
        *(MLAS u32x4*)(lds + O_VS + ((2 * p) * PV + 8 * d8) * 2) = vrow[0];
        *(MLAS u32x4*)(lds + O_VS + ((2 * p + 1) * PV + 8 * d8) * 2) = vrow[1];
        }
        if (!(VAR & 1) && ch + 1 < c_end) { if (ch + 1 >= c_begin) MLS_LOAD_RAW(ch + 1); else MLS_LOAD_KV(ch + 1); }
        }
        __syncthreads();
        f32x4 nacc[4], dacc = (f32x4){0.f, 0.f, 0.f, 0.f};
        { MLS_LANE();
        if (!full) { nacc[0] = nacc[1] = nacc[2] = nacc[3] = dacc; } else
        if (!(VAR & 8)) {
        { const int tb = wave >> 1; const MLAS float* sc = (const MLAS float*)(lds + ((ch & 1) ? O_SCAL2 : O_SCAL));
#pragma unroll
          for (int q = 0; q < 2; ++q) { const int sb = 2 * (wave & 1) + q;
            MLAS unsigned short* scp = (MLAS unsigned short*)(lds + O_SC) + (16 * tb + 4 * g) * PT + 16 * sb + fr;
            if (sb <= tb) { f32x4 acc = (f32x4){0.f, 0.f, 0.f, 0.f};
#pragma unroll
                for (int ks = 0; ks < 4; ++ks) acc = MFMA16(LDFRAG(O_QS + ((16 * tb + fr) * PQ + 32 * ks + 8 * g) * 2), LDFRAG(O_KS + ((16 * sb + fr) * PQ + 32 * ks + 8 * g) * 2), acc);
                const int s = 16 * sb + fr; const float us = sc[s];
                const f32x4 mmt = *(const MLAS f32x4*)(sc + 128 + 16 * tb + 4 * g);
#pragma unroll
                for (int i = 0; i < 4; ++i) { const int t = 16 * tb + 4 * g + i; const float wgt = (s <= t) ? __expf(us - mmt[i]) : 0.f;
                    scp[i * PT] = (unsigned short)(cvt2(acc[i] * wgt, 0.f) & 0xffffu); }
            } else {
#pragma unroll
                for (int i = 0; i < 4; ++i) scp[i * PT] = 0; }
          } }
        { bf16x8 bfr[4];
#pragma unroll
          for (int ks = 0; ks < 4; ++ks) bfr[ks] = LDFRAG(O_CB + ((16 * wave + fr) * PQ + 32 * ks + 8 * g) * 2);
          const MLAS float* mmp = (const MLAS float*)(lds + ((ch & 1) ? O_SCAL2 : O_SCAL)) + 128;
#pragma unroll
          for (int tbk = 0; tbk < 4; ++tbk) { f32x4 acc = (f32x4){0.f, 0.f, 0.f, 0.f};
#pragma unroll
              for (int ks = 0; ks < 4; ++ks) acc = MFMA16(LDFRAG(O_QS + ((16 * tbk + fr) * PQ + 32 * ks + 8 * g) * 2), bfr[ks], acc);
              const f32x4 mv = *(const MLAS f32x4*)(mmp + 16 * tbk + 4 * g); const f32x4 wv = {__expf(mstc - mv[0]), __expf(mstc - mv[1]), __expf(mstc - mv[2]), __expf(mstc - mv[3])}; nacc[tbk] = acc * wv; }
          if (wave < 4) {
#pragma unroll
              for (int ks = 0; ks < 4; ++ks) dacc = MFMA16(LDFRAG(O_QS + ((16 * wave + fr) * PQ + 32 * ks + 8 * g) * 2), LDFRAG(O_CB + ((128 + fr) * PQ + 32 * ks + 8 * g) * 2), dacc);
              const f32x4 mv = *(const MLAS f32x4*)(mmp + 16 * wave + 4 * g); const f32x4 wv = {__expf(mstc - mv[0]), __expf(mstc - mv[1]), __expf(mstc - mv[2]), __expf(mstc - mv[3])}; dacc = dacc * wv; } }
        } else { nacc[0] = nacc[1] = nacc[2] = nacc[3] = dacc; }
        }
        if (full) __syncthreads();
        { MLS_LANE();
        if (!(VAR & 8)) {
        if (full) {
        bf16x8 vfr[2];
#pragma unroll
        for (int ks = 0; ks < 2; ++ks) vfr[ks] = trfrag(lds, O_VS + ((32 * ks) * PV + 16 * wave) * 2, PV, fr, g);
#pragma unroll
        for (int tbk = 0; tbk < 4; ++tbk) {
#pragma unroll
            for (int ks = 0; ks < 2; ++ks) if (32 * ks <= 16 * tbk + 15) nacc[tbk] = MFMA16(LDFRAG(O_SC + ((16 * tbk + fr) * PT + 32 * ks + 8 * g) * 2), vfr[ks], nacc[tbk]);
            MLAS unsigned short* hp = (MLAS unsigned short*)(lds + O_HB) + (16 * tbk + 4 * g) * PQ + 16 * wave + fr;
#pragma unroll
            for (int i = 0; i < 4; i += 2) { const unsigned pk = cvt2(nacc[tbk][i], nacc[tbk][i + 1]); hp[i * PQ] = (unsigned short)(pk & 0xffffu); hp[(i + 1) * PQ] = (unsigned short)(pk >> 16); } }
        if (wave < 4) {
#pragma unroll
            for (int ks = 0; ks < 2; ++ks) if (32 * ks <= 16 * wave + 15) dacc = MFMA16(LDFRAG(O_SC + ((16 * wave + fr) * PT + 32 * ks + 8 * g) * 2), trfrag(lds, O_VS + ((32 * ks) * PV + 128) * 2, PV, fr, g), dacc);
            if (fr == 0) *(MLAS f32x4*)(lds + O_DEN + (16 * wave + 4 * g) * 4) = dacc; }
        }
        { bf16x8 afr[2];
#pragma unroll
          for (int ks = 0; ks < 2; ++ks) afr[ks] = trfrag(lds, O_KW + ((32 * ks) * PQ + 16 * wave) * 2, PQ, fr, g);
#pragma unroll
          for (int eb = 0; eb < 9; ++eb) { f32x4 c = cacc[eb] * decay;
#pragma unroll
              for (int ks = 0; ks < 2; ++ks) c = MFMA16(afr[ks], trfrag(lds, O_VS + ((32 * ks) * PV + 16 * eb) * 2, PV, fr, g), c);
              cacc[eb] = c;
              u32x2 w; w.x = cvt2(c[0], c[1]); w.y = cvt2(c[2], c[3]);
              *(MLAS u32x2*)(lds + O_CB + ((16 * eb + fr) * PQ + 16 * wave + 4 * g) * 2) = w; } }
        }
        }
        __syncthreads();
        { MLS_LANE();
        if (full && !(VAR & 2)) { const MLAS float* scd = (const MLAS float*)(lds + ((ch & 1) ? O_SCAL2 : O_SCAL)); const MLAS float* bcp = scd + 64; const MLAS float* mmq = scd + 128;
#pragma unroll
          for (int it = 0; it < 2; ++it) { const int t = wave * 8 + 4 * it + (lane >> 4), c0 = 8 * (lane & 15);
              float nn[8]; { const u32x4 nw = *(const MLAS u32x4*)(lds + O_HB + (t * PQ + c0) * 2); unpk8(nw, nn); } const float den = ((const MLAS float*)(lds + O_DEN))[t];
              float ss = (nn[0] * nn[0] + nn[1] * nn[1]) + (nn[2] * nn[2] + nn[3] * nn[3]) + (nn[4] * nn[4] + nn[5] * nn[5]) + (nn[6] * nn[6] + nn[7] * nn[7]);
              ss += __shfl_xor(ss, 1); ss += __shfl_xor(ss, 2); ss += __shfl_xor(ss, 4); ss += __shfl_xor(ss, 8);
              const float dn = fmaxf(fabsf(den), __expf(-(bcp[t] + mmq[t])));
              const float rs = __builtin_amdgcn_rsqf(ss * (1.0f / 128.0f) + 1e-5f * dn * dn);
              float o[8]; unpk8(og[it], o); float gm[8]; { const f32x4 ga = *(const MLAS f32x4*)(lds + O_GM + c0 * 4), gb = *(const MLAS f32x4*)(lds + O_GM + c0 * 4 + 16); gm[0] = ga[0]; gm[1] = ga[1]; gm[2] = ga[2]; gm[3] = ga[3]; gm[4] = gb[0]; gm[5] = gb[1]; gm[6] = gb[2]; gm[7] = gb[3]; }
              float y[8];
#pragma unroll
              for (int j = 0; j < 8; ++j) y[j] = nn[j] * rs * gm[j] * __builtin_amdgcn_rcpf(1.0f + __expf(-o[j]));
              u32x4 w; w.x = cvt2(y[0], y[1]); w.y = cvt2(y[2], y[3]); w.z = cvt2(y[4], y[5]); w.w = cvt2(y[6], y[7]);
              *(u32x4*)(P.MIX + (seq0 + t0 + t) * MIXP + h * 128 + c0) = w; } }
        }
    }
#undef MLS_LOAD_RAW
#undef MLS_LOAD_KV
}
#undef MFMA16
#undef LDFRAG
}

constexpr int NL = 4, BATCH = 16, SEQ = 2048, DM = 1024, M = BATCH * SEQ, FF = 2816, NIN = 3592;
constexpr int ZP = 3584;
constexpr int ZQM = 0, ZKM = 512, ZVM = 1024, ZOM = 1536, ZQA = 2048, ZKA = 2560, ZVA = 3072;
constexpr int NGU = 2 * FF;
constexpr float EPS = 1e-6f, HEAD_EPS = 1e-5f;
constexpr float C2 = 0.125f * 1.4426950408889634f;
constexpr int NWAVES = 8;
#ifndef MK_ONE_LAUNCH
#define MK_ONE_LAUNCH 1
#endif
constexpr bool USE_NAIVE_ATTN = false, USE_NAIVE_MLSTM = false;
constexpr bool SPLIT_MIXERS = false;
#ifndef ATTN_ORDER
#define ATTN_ORDER 1
#endif
#ifndef MLS_SEGS
#define MLS_SEGS 2
#endif
#ifndef MLS_SPLIT
#define MLS_SPLIT 16
#endif
#ifndef PROBE_MLS_VAR
#define PROBE_MLS_VAR 0
#endif
#ifndef PROBE_GU_VAR
#define PROBE_GU_VAR 1
#endif
#ifndef PROBE_DUP
#define PROBE_DUP 0
#endif
constexpr int N_PHASES = 2 + 6 * NL;

constexpr size_t MiB = 1u << 20;
constexpr size_t WS_CTL = 0, CTL_ZERO_BYTES = 1 * MiB;
constexpr size_t WIN_L = (size_t)ZP * DM * 2, WOUT_L = (size_t)DM * DM * 2, WGU_L = (size_t)NGU * DM * 2, WDN_L = (size_t)DM * FF * 2;
constexpr size_t WS_WIN = 2 * MiB, WS_WOUT = WS_WIN + NL * WIN_L, WS_WGU = WS_WOUT + NL * WOUT_L, WS_WDN = WS_WGU + NL * WGU_L;
constexpr size_t WS_WG = WS_WDN + NL * WDN_L;
constexpr size_t WS_COS = WS_WG + (size_t)NL * 8 * DM * 4, WS_SIN = WS_COS + (size_t)SEQ * 32 * 4;
constexpr size_t WS_ROWSS = 106 * MiB;
constexpr size_t WS_GATES = 108 * MiB;
constexpr size_t WS_SCAL = 109 * MiB;
constexpr size_t WS_CHT = 111 * MiB;
constexpr size_t WS_XB = 112 * MiB;
constexpr size_t WS_MIX = 176 * MiB;
constexpr size_t WS_Z = 240 * MiB;
constexpr size_t WS_SCALX = WS_Z + (size_t)M * ZP * 2;
constexpr size_t WS_END = WS_SCALX + (size_t)256 * SEQ * 16;
static_assert(WS_SIN + (size_t)SEQ * 32 * 4 <= WS_ROWSS && WS_END <= 512 * MiB, "d_ws map");
constexpr int CW_TMO = 0, CW_CODE = 1, CW_BAR = 4096, CW_QUEUE = 8192;

constexpr int RING_OFF = 0, RING_BYTES = 147456;
constexpr int LDSCTL_OFF = RING_BYTES, MISC_OFF = LDSCTL_OFF + 320;
constexpr int LDS_BYTES = 155648;

typedef float f32x4g __attribute__((ext_vector_type(4)));
__device__ __forceinline__ float bf2f(unsigned short b) { return __uint_as_float((unsigned)b << 16); }
__device__ __forceinline__ void unpack8(const v4u& w, float* f) {
    f[0] = __uint_as_float(w.x << 16); f[1] = __uint_as_float(w.x & 0xffff0000u); f[2] = __uint_as_float(w.y << 16); f[3] = __uint_as_float(w.y & 0xffff0000u);
    f[4] = __uint_as_float(w.z << 16); f[5] = __uint_as_float(w.z & 0xffff0000u); f[6] = __uint_as_float(w.w << 16); f[7] = __uint_as_float(w.w & 0xffff0000u);
}
__device__ __forceinline__ v4u pack8(const float* f) {
    v4u w; w.x = pg8::cvt_pk_bf16(f[0], f[1]); w.y = pg8::cvt_pk_bf16(f[2], f[3]); w.z = pg8::cvt_pk_bf16(f[4], f[5]); w.w = pg8::cvt_pk_bf16(f[6], f[7]); return w;
}

struct Args { const float* in[18]; float* out; unsigned char* ws; int ph_lo, ph_hi, mix_sel, pad; };
struct Frame {
    LAS unsigned char* lds;
    volatile LAS unsigned* MISC;
    int vcu, G;
    const Args* a;
};
#define PHASE_TID() int tid_ = threadIdx.x; asm volatile("" : "+v"(tid_)); const int tid = tid_, lane = tid & 63, wave = __builtin_amdgcn_readfirstlane(tid >> 6); (void)tid; (void)lane; (void)wave
#define FIN(k) (F.a->in[k])
#define FWS(T, off) ((T*)(F.a->ws + (off)))

__device__ __forceinline__ float wave_sum(float v) {
#pragma unroll
    for (int o = 1; o < 64; o <<= 1) v += __shfl_xor(v, o);
    return v;
}

struct WItem { const float* W; const float* gk; bf16* WT; int ldw, src, K, dst, k0; };
__device__ __forceinline__ void p0_load(const WItem& w, int lane, f32x4 (&v)[8], float (&gs)[8]) {
#pragma unroll
    for (int i = 0; i < 8; ++i) { const int k = w.k0 + 8 * i + (lane >> 3); v[i] = *(const GAS f32x4*)(w.W + (size_t)k * w.ldw + w.src + 4 * (lane & 7)); }
    if (w.gk) {
#pragma unroll
        for (int i = 0; i < 8; ++i) gs[i] = ((const GAS float*)w.gk)[w.k0 + 8 * i + (lane >> 3)];
    } else {
#pragma unroll
        for (int i = 0; i < 8; ++i) gs[i] = 1.0f; }
}
__device__ __forceinline__ void p0_store(const WItem& w, LAS float* scr, int lane, const f32x4 (&v)[8], const float (&gs)[8]) {
#pragma unroll
    for (int i = 0; i < 8; ++i) { LAS float* s = scr + (8 * i + (lane >> 3)) * 33 + 4 * (lane & 7); const f32x4 x = v[i] * gs[i]; s[0] = x[0]; s[1] = x[1]; s[2] = x[2]; s[3] = x[3]; }
    LDS_WAIT(); asm volatile("" ::: "memory");
    const int c = lane & 7;
#pragma unroll
    for (int j = 0; j < 4; ++j) { const int n = (lane >> 3) + 8 * j; const LAS float* s = scr + (8 * c) * 33 + n;
        v4u o; o.x = pg8::cvt_pk_bf16(s[0 * 33], s[1 * 33]); o.y = pg8::cvt_pk_bf16(s[2 * 33], s[3 * 33]); o.z = pg8::cvt_pk_bf16(s[4 * 33], s[5 * 33]); o.w = pg8::cvt_pk_bf16(s[6 * 33], s[7 * 33]);
        *(GAS v4u*)(w.WT + (size_t)(w.dst + n) * w.K + w.k0 + 8 * c) = o; }
    LDS_WAIT(); asm volatile("" ::: "memory");
}
__constant__ double ROPE_INV[32] = {1.0, 0.7498942093324559, 0.5623413251903491, 0.4216965034285822, 0.31622776601683794, 0.23713737056616552, 0.1778279410038923, 0.1333521432163324,
    0.1, 0.07498942093324558, 0.05623413251903491, 0.042169650342858224, 0.03162277660168379, 0.023713737056616554, 0.01778279410038923, 0.01333521432163324,
    0.01, 0.007498942093324558, 0.005623413251903491, 0.004216965034285823, 0.0031622776601683794, 0.0023713737056616554, 0.0017782794100389228, 0.001333521432163324,
    0.001, 0.0007498942093324559, 0.0005623413251903491, 0.00042169650342858224, 0.00031622776601683794, 0.00023713737056616554, 0.00017782794100389227, 0.0001333521432163324};
__device__ __forceinline__ void sincos_d(double a, double& s, double& c) {
    const double k = __builtin_rint(a * 0.6366197723675814);
    double r = __builtin_fma(-k, 1.5707963267948966, a); r = __builtin_fma(-k, 6.123233995736766e-17, r);
    const double r2 = r * r;
    double sp = -7.647163731819816e-13; sp = sp * r2 + 1.6059043836821613e-10; sp = sp * r2 - 2.505210838544172e-08; sp = sp * r2 + 2.7557319223985893e-06; sp = sp * r2 - 0.0001984126984126984; sp = sp * r2 + 0.008333333333333333; sp = sp * r2 - 0.16666666666666666;
    const double sn = r + r * r2 * sp;
    double cp = 4.779477332387385e-14; cp = cp * r2 - 1.1470745597729725e-11; cp = cp * r2 + 2.08767569878681e-09; cp = cp * r2 - 2.755731922398589e-07; cp = cp * r2 + 2.48015873015873e-05; cp = cp * r2 - 0.001388888888888889; cp = cp * r2 + 0.041666666666666664; cp = cp * r2 - 0.5;
    const double cs = 1.0 + r2 * cp;
    const int q = (int)((long long)k & 3);
    s = (q == 0) ? sn : (q == 1) ? cs : (q == 2) ? -sn : -cs;
    c = (q == 0) ? cs : (q == 1) ? -sn : (q == 2) ? -cs : sn;
}
__device__ __forceinline__ void p0_prologue(Frame& F) {
    PHASE_TID();
    LAS float* scr = (LAS float*)(F.lds + RING_OFF + wave * 16384);
    const int gw = F.vcu * NWAVES + wave, NGW = F.G * NWAVES;
    constexpr int I_IN = 16 * 112, I_OUT = 16 * 32, I_GU = 16 * 176, I_DN = 44 * 32, I_L = I_IN + I_OUT + I_GU + I_DN;
#define P0_DECODE(it_, w_) do { const int l_ = (it_) / I_L; int r_ = (it_) % I_L; \
        if (r_ < I_IN) { const int kb_ = r_ / 112, G_ = r_ % 112; int src_; \
            if (G_ < 64) src_ = 32 * G_; \
            else if (G_ < 96) { const int rr_ = (G_ - 64) & 15, tile_ = rr_ >> 3, bj_ = (rr_ >> 2) & 1, grp_ = rr_ & 3; src_ = (G_ < 80 ? 2056 : 2568) + (2 * tile_ + (grp_ >> 1)) * 128 + (grp_ & 1) * 64 + bj_ * 32; } \
            else src_ = 3080 + 32 * (G_ - 96); \
            w_.W = FIN(2) + (size_t)l_ * DM * NIN; w_.gk = FIN(1) + l_ * DM; w_.WT = FWS(bf16, WS_WIN) + (size_t)l_ * ZP * DM; w_.ldw = NIN; w_.src = src_; w_.K = DM; w_.dst = 32 * G_; w_.k0 = 64 * kb_; } \
        else if ((r_ -= I_IN) < I_OUT) { const int kb_ = r_ / 32, G_ = r_ % 32; \
            w_.W = FIN(12) + (size_t)l_ * DM * DM; w_.gk = nullptr; w_.WT = FWS(bf16, WS_WOUT) + (size_t)l_ * DM * DM; w_.ldw = DM; w_.src = 32 * G_; w_.K = DM; w_.dst = 32 * G_; w_.k0 = 64 * kb_; } \
        else if ((r_ -= I_OUT) < I_GU) { const int kb_ = r_ / 176, G_ = r_ % 176, tile_ = G_ >> 3, q_ = G_ & 7; \
            w_.W = (q_ < 4 ? FIN(14) : FIN(15)) + (size_t)l_ * DM * FF; w_.gk = FIN(13) + l_ * DM; w_.WT = FWS(bf16, WS_WGU) + (size_t)l_ * NGU * DM; w_.ldw = FF; w_.src = 128 * tile_ + 32 * (q_ & 3); w_.K = DM; w_.dst = 32 * G_; w_.k0 = 64 * kb_; } \
        else { r_ -= I_GU; const int kb_ = r_ / 32, G_ = r_ % 32; \
            w_.W = FIN(16) + (size_t)l_ * FF * DM; w_.gk = nullptr; w_.WT = FWS(bf16, WS_WDN) + (size_t)l_ * DM * FF; w_.ldw = DM; w_.src = 32 * G_; w_.K = FF; w_.dst = 32 * G_; w_.k0 = 64 * kb_; } } while (0)
    { WItem wa, wb; f32x4 va[8], vb[8]; float ga[8], gb[8]; int it = gw; const int NIT = NL * I_L;
      if (it < NIT) { P0_DECODE(it, wa); p0_load(wa, lane, va, ga); }
#pragma unroll 1
      while (it < NIT) {
          const bool hb = it + NGW < NIT; if (hb) { P0_DECODE(it + NGW, wb); p0_load(wb, lane, vb, gb); }
          p0_store(wa, scr, lane, va, ga); it += NGW; if (it >= NIT) break;
          const bool ha = it + NGW < NIT; if (ha) { P0_DECODE(it + NGW, wa); p0_load(wa, lane, va, ga); }
          p0_store(wb, scr, lane, vb, gb); it += NGW; } }
#undef P0_DECODE
    const int gt = (F.vcu * NWAVES + wave) * 64 + lane, NGT = F.G * NWAVES * 64;
    for (int i = gt; i < NL * 16 * DM; i += NGT) { const int l = i / (16 * DM), j = (i / DM) & 15, k = i % DM; const float v = (j < 8) ? FIN(2)[((size_t)l * DM + k) * NIN + 2048 + j] * FIN(1)[l * DM + k] : 0.f; FWS(bf16, WS_WG)[i] = (bf16)(pg8::cvt_pk_bf16(v, 0.f) & 0xffffu); }
    for (int i = gt; i < SEQ * 32; i += NGT) { const int pos = i >> 5, fi = i & 31; double s, c; sincos_d((double)pos * ROPE_INV[fi], s, c); _Float16* tp = FWS(_Float16, WS_COS) + ((size_t)pos * 4 + (fi >> 3)) * 16 + (fi & 7); tp[0] = (_Float16)(float)c; tp[8] = (_Float16)(float)s; }
#pragma unroll 1
    for (int m0 = gw * 4; m0 < M; m0 += NGW * 4) {
        f32x4 v[4][4];
#pragma unroll
        for (int r = 0; r < 4; ++r) { const GAS f32x4* xr = (const GAS f32x4*)(FIN(0) + (size_t)(m0 + r) * DM) + lane;
#pragma unroll
            for (int j = 0; j < 4; ++j) v[r][j] = xr[64 * j]; }
#pragma unroll
        for (int r = 0; r < 4; ++r) { float s = 0.f;
#pragma unroll
            for (int j = 0; j < 4; ++j) s += (v[r][j].x * v[r][j].x + v[r][j].y * v[r][j].y) + (v[r][j].z * v[r][j].z + v[r][j].w * v[r][j].w);
            s = wave_sum(s);
            GAS unsigned long long* o8 = (GAS unsigned long long*)(FWS(bf16, WS_XB) + (size_t)(m0 + r) * DM) + lane;
#pragma unroll
            for (int j = 0; j < 4; ++j) o8[64 * j] = (unsigned long long)pg8::cvt_pk_bf16(v[r][j].x, v[r][j].y) | ((unsigned long long)pg8::cvt_pk_bf16(v[r][j].z, v[r][j].w) << 32);
            if (lane < 16) FWS(float, WS_ROWSS)[(size_t)(m0 + r) * 16 + lane] = (lane == 0) ? s : 0.f; }
    }
}


__device__ __forceinline__ void gates_phase(Frame& F, int l) {
    PHASE_TID();
    typedef short bf16x8g __attribute__((ext_vector_type(8)));
    const int gw = F.vcu * NWAVES + wave, fr = lane & 15, g = lane >> 4;
    const int rows_per_wave = M / (F.G * NWAVES);
    for (int r0 = gw * rows_per_wave; r0 < (gw + 1) * rows_per_wave; r0 += 16) {
        const bf16* xa = FWS(bf16, WS_XB) + (size_t)(r0 + fr) * DM + 8 * g; const bf16* wb = FWS(bf16, WS_WG) + ((size_t)l * 16 + fr) * DM + 8 * g;
        f32x4 qs[4];
#pragma unroll
        for (int i = 0; i < 4; ++i) qs[i] = *(const GAS f32x4*)(FWS(float, WS_ROWSS) + (size_t)(r0 + 4 * g + i) * 16 + 4 * (fr & 3));
        f32x4 acc = {0.f, 0.f, 0.f, 0.f};
#pragma unroll 1
        for (int hk = 0; hk < 2; ++hk) {
            bf16x8g a[16];
#pragma unroll
            for (int ks = 0; ks < 16; ++ks) a[ks] = *(const GAS bf16x8g*)(xa + 32 * (16 * hk + ks));
#pragma unroll
            for (int ks = 0; ks < 16; ks += 4) asm volatile("" : "+v"(a[ks]), "+v"(a[ks + 1]), "+v"(a[ks + 2]), "+v"(a[ks + 3]));
#pragma unroll
            for (int ks = 0; ks < 16; ++ks) { const bf16x8g b = *(const GAS bf16x8g*)(wb + 32 * (16 * hk + ks)); acc = __builtin_amdgcn_mfma_f32_16x16x32_bf16(a[ks], b, acc, 0, 0, 0); }
        }
#pragma unroll
        for (int i = 0; i < 4; ++i) { const int row = r0 + 4 * g + i;
            const f32x4 q = qs[i]; float s = (q[0] + q[1]) + (q[2] + q[3]);
            s += __shfl_xor(s, 1); s += __shfl_xor(s, 2);
            const float rs = __builtin_amdgcn_rsqf(s * (1.0f / 1024.0f) + EPS);
            if (fr < 8) FWS(float, WS_GATES)[(size_t)row * 8 + fr] = acc[i] * rs; }
    }
}

__device__ __forceinline__ void conv_phase(Frame& F, int l) {
    PHASE_TID();
    const int chunk = tid & 127, grp = tid >> 7, col = 8 * chunk;
    const int rbase = (int)blockIdx.x * (M / F.G) + grp * 32;
    const float* cw = FIN(3) + (size_t)l * 4096 + col; const float* cb = FIN(4) + (size_t)l * 1024 + col;
    float wt[4][8], bs[8];
#pragma unroll
    for (int j = 0; j < 4; ++j) { const f32x4 a = *(const GAS f32x4*)(cw + j * 1024), b = *(const GAS f32x4*)(cw + j * 1024 + 4); wt[j][0] = a[0]; wt[j][1] = a[1]; wt[j][2] = a[2]; wt[j][3] = a[3]; wt[j][4] = b[0]; wt[j][5] = b[1]; wt[j][6] = b[2]; wt[j][7] = b[3]; }
    { const f32x4 a = *(const GAS f32x4*)cb, b = *(const GAS f32x4*)(cb + 4); bs[0] = a[0]; bs[1] = a[1]; bs[2] = a[2]; bs[3] = a[3]; bs[4] = b[0]; bs[5] = b[1]; bs[6] = b[2]; bs[7] = b[3]; }
    const float osc = (chunk >= 64) ? 0.08838834764831845f : 1.0f;
    const bf16* zc = FWS(bf16, WS_Z) + col; bf16* qc = (bf16*)(F.a->out) + col;
    float w0[8], w1[8], w2[8];
    if ((rbase & (SEQ - 1)) == 0) {
#pragma unroll
        for (int x = 0; x < 8; ++x) { w0[x] = 0.f; w1[x] = 0.f; w2[x] = 0.f; }
    } else { const v4u a = *(const GAS v4u*)(zc + (size_t)(rbase - 3) * ZP), b = *(const GAS v4u*)(zc + (size_t)(rbase - 2) * ZP), c = *(const GAS v4u*)(zc + (size_t)(rbase - 1) * ZP); unpack8(a, w0); unpack8(b, w1); unpack8(c, w2); }
#pragma unroll 8
    for (int rr = 0; rr < 32; ++rr) { const size_t row = (size_t)(rbase + rr);
        float cur[8], y[8]; { const v4u rw = *(const GAS v4u*)(zc + row * ZP); unpack8(rw, cur); }
#pragma unroll
        for (int x = 0; x < 8; ++x) { const float a = bs[x] + w0[x] * wt[0][x] + w1[x] * wt[1][x] + w2[x] * wt[2][x] + cur[x] * wt[3][x];
            y[x] = a * __builtin_amdgcn_rcpf(1.0f + __expf(-a)) * osc; w0[x] = w1[x]; w1[x] = w2[x]; w2[x] = cur[x]; }
        *(GAS v4u*)(qc + row * 1024) = pack8(y); }
    { const int gw = (int)blockIdx.x * NWAVES + wave; if (gw < 64 * 32) { const int unit = gw >> 5, c = gw & 31, hh = unit & 3; const size_t row = (size_t)(unit >> 2) * SEQ + 64 * c + lane;
        const float gi = FWS(float, WS_GATES)[row * 8 + hh] + FIN(5)[l * 8 + hh], gf = FWS(float, WS_GATES)[row * 8 + 4 + hh] + FIN(5)[l * 8 + 4 + hh];
        const float lf = fminf(gf, 0.f) - log1pf(__expf(-fabsf(gf)));
        const float bc = mls::scan_add(lf, lane); const float u = gi - bc; const float amax = mls::scan_max(u, lane);
        *(GAS f32x4*)(FWS(float, WS_SCAL) + ((size_t)unit * SEQ + 64 * c + lane) * 4) = (f32x4){u, bc, amax, 0.f};
        const float blast = __shfl(bc, 63), gmax = blast + __shfl(amax, 63);
        if (lane == 0) { FWS(float, WS_CHT)[(unit * 32 + c) * 2] = blast; FWS(float, WS_CHT)[(unit * 32 + c) * 2 + 1] = gmax; } } }
}

constexpr int RSTD_OFF = LDSCTL_OFF + 1024;
__device__ __forceinline__ pg8::RstdTab stage_rstd(Frame& F, const pg8::StaticOrder& S) {
    PHASE_TID();
    pg8::Unit u0; pg8::RstdTab rt; rt.tab = (const LAS float*)(F.lds + RSTD_OFF); rt.pm0 = 0;
    if (!S.next(0, u0)) return rt;
    rt.pm0 = u0.pm;
#pragma unroll 1
    for (int k = 0; k < 3; ++k) { const int pm = u0.pm + 8 * k; if (pm >= M / 256) break;
        const float* p = FWS(float, WS_ROWSS) + ((size_t)pm * 256 + (tid >> 1)) * 16 + 8 * (tid & 1);
        const f32x4 a = *(const GAS f32x4*)p, b = *(const GAS f32x4*)(p + 4);
        float s = ((a[0] + a[1]) + (a[2] + a[3])) + ((b[0] + b[1]) + (b[2] + b[3]));
        s += __shfl_xor(s, 1);
        if ((tid & 1) == 0) ((LAS float*)(F.lds + RSTD_OFF))[k * 256 + (tid >> 1)] = __builtin_amdgcn_rsqf(s * (1.0f / 1024.0f) + EPS); }
    __syncthreads();
    return rt;
}

__device__ __forceinline__ void frame_init(Frame& F, const Args& args, unsigned char* lds) {
    F.lds = (LAS unsigned char*)lds;
    F.MISC = (volatile LAS unsigned*)(F.lds + MISC_OFF);
    F.G = gridDim.x; { const int bx = blockIdx.x; F.vcu = (F.G % 8 == 0) ? (bx % 8) * (F.G / 8) + bx / 8 : bx; }
    F.a = &args;
}

__device__ __forceinline__ float layer_lambda(Frame& F, int l, float lam_init) {
    float a = 0.f, b = 0.f;
    for (int i = 0; i < 64; ++i) { a += FIN(7)[l * 64 + i] * FIN(8)[l * 64 + i]; b += FIN(9)[l * 64 + i] * FIN(10)[l * 64 + i]; }
    return __expf(a) - __expf(b) + lam_init;
}
__device__ __forceinline__ void attn_naive_unit(Frame& F, int l, int b, int h, int qb, float lam, float lam_init) {
    PHASE_TID();
    const int vh = tid >> 8, c = (tid >> 7) & 1, r = tid & 127;
    const int qpos = qb * 128 + r; const size_t row = (size_t)b * SEQ + qpos;
    LAS float* Ks = (LAS float*)(F.lds + RING_OFF); LAS float* Vs = Ks + 4096; LAS float* XCH = Vs + 4096; LAS float* SSQ = XCH + 16384;
    float q[64];
#pragma unroll
    for (int i = 0; i < 8; ++i) { const v4u w = *(const GAS v4u*)(FWS(bf16, WS_Z) + row * ZP + ZQA + h * 128 + c * 64 + 8 * i); unpack8(w, q + 8 * i); }
    float o[64];
#pragma unroll
    for (int e = 0; e < 64; ++e) o[e] = 0.f;
    float mrun = -INFINITY, lsum = 0.f;
    const int nk = qb * 128 + 128;
    for (int j0 = 0; j0 < nk; j0 += 32) {
        __syncthreads();
        { const int cc = tid >> 8, key = (tid >> 3) & 31, d8 = (tid & 7) * 8; float f[8];
          const v4u w = *(const GAS v4u*)(FWS(bf16, WS_Z) + ((size_t)b * SEQ + j0 + key) * ZP + ZKA + h * 128 + cc * 64 + d8); unpack8(w, f);
#pragma unroll
          for (int i = 0; i < 8; ++i) Ks[cc * 2048 + key * 64 + d8 + i] = f[i]; }
        { const int key = tid >> 4, e8 = (tid & 15) * 8; float f[8];
          const v4u w = *(const GAS v4u*)(FWS(bf16, WS_Z) + ((size_t)b * SEQ + j0 + key) * ZP + ZVA + h * 128 + e8); unpack8(w, f);
#pragma unroll
          for (int i = 0; i < 8; ++i) Vs[key * 128 + e8 + i] = f[i]; }
        __syncthreads();
#pragma unroll 1
        for (int key = 0; key < 32; ++key) {
            const LAS f32x4* kp = (const LAS f32x4*)(Ks + c * 2048 + key * 64); float d0 = 0.f, d1 = 0.f;
#pragma unroll
            for (int d = 0; d < 16; d += 2) { const f32x4 k0 = kp[d], k1 = kp[d + 1];
                d0 += q[4 * d] * k0.x + q[4 * d + 1] * k0.y + q[4 * d + 2] * k0.z + q[4 * d + 3] * k0.w;
                d1 += q[4 * d + 4] * k1.x + q[4 * d + 5] * k1.y + q[4 * d + 6] * k1.z + q[4 * d + 7] * k1.w; }
            const float sv = (j0 + key <= qpos) ? (d0 + d1) : -INFINITY;
            if (sv > mrun) { const float alpha = exp2f(mrun - sv); lsum *= alpha;
#pragma unroll
                for (int e = 0; e < 64; ++e) o[e] *= alpha;
                mrun = sv; }
            const float p = exp2f(sv - mrun); lsum += p; const LAS f32x4* vp = (const LAS f32x4*)(Vs + key * 128 + vh * 64);
#pragma unroll
            for (int e = 0; e < 16; ++e) { const f32x4 v = vp[e]; o[4 * e] += p * v.x; o[4 * e + 1] += p * v.y; o[4 * e + 2] += p * v.z; o[4 * e + 3] += p * v.w; }
        }
    }
    const float inv = 1.0f / lsum;
#pragma unroll
    for (int e = 0; e < 64; ++e) o[e] *= inv;
    __syncthreads();
    if (c == 1) {
#pragma unroll
        for (int e = 0; e < 64; ++e) XCH[(vh * 128 + r) * 64 + e] = o[e]; }
    __syncthreads();
    float ss = 0.f;
    if (c == 0) {
#pragma unroll
        for (int e = 0; e < 64; ++e) { o[e] = o[e] - lam * XCH[(vh * 128 + r) * 64 + e]; ss += o[e] * o[e]; }
        SSQ[vh * 128 + r] = ss; }
    __syncthreads();
    if (c == 0) {
        const float rs = rsqrtf((SSQ[r] + SSQ[128 + r]) * (1.0f / 128.0f) + HEAD_EPS) * (1.0f - lam_init);
        const float* g = FIN(11) + l * 512 + h * 128 + vh * 64;
#pragma unroll
        for (int i = 0; i < 8; ++i) { float f[8];
#pragma unroll
            for (int j = 0; j < 8; ++j) f[j] = o[8 * i + j] * rs * g[8 * i + j];
            *(GAS v4u*)(FWS(bf16, WS_MIX) + row * DM + 512 + h * 128 + vh * 64 + 8 * i) = pack8(f); }
    }
    __syncthreads();
}

constexpr int MLP = 132;
__device__ __forceinline__ void mlstm_naive_unit(Frame& F, int l, int b, int h) {
    PHASE_TID();
    LAS float* Qs = (LAS float*)(F.lds + RING_OFF); LAS float* Ks = Qs + 64 * MLP; LAS float* Vs = Ks + 64 * MLP; LAS float* Ss = Vs + 64 * MLP;
    LAS float* sc_ii = Ss + 64 * 65; LAS float* sc_bc = sc_ii + 64; LAS float* sc_mt = sc_bc + 64; LAS float* sc_wi = sc_mt + 64; LAS float* sc_ws = sc_wi + 64; LAS float* sc_rd = sc_ws + 64;
    LAS float* nvec = sc_rd + 64; LAS float* sc_misc = nvec + 128;
    LAS float* HI = sc_misc + 16;
    LAS float* Hs = Qs;
    const int e = tid >> 2, dq = tid & 3;
    float C[32];
#pragma unroll
    for (int i = 0; i < 32; ++i) C[i] = 0.f;
    if (tid < 128) nvec[tid] = 0.f;
    if (tid == 0) { sc_misc[0] = 0.f; sc_misc[1] = 0.f; }
    const float bi = FIN(5)[l * 8 + h], bfg = FIN(5)[l * 8 + 4 + h];
    const float* cw = FIN(3) + (size_t)l * 4 * 1024; const float* cb = FIN(4) + (size_t)l * 1024;
    const float kscale = 0.08838834764831845f;
    __syncthreads();
    for (int ch = 0; ch < 32; ++ch) {
        const int t0 = ch * 64; const size_t rowb = (size_t)b * SEQ + t0;
#pragma unroll 1
        for (int idx = tid; idx < 64 * 128; idx += 512) { const int t = idx >> 7, d = idx & 127;
            float aq = cb[h * 128 + d], ak = cb[512 + h * 128 + d];
#pragma unroll
            for (int j = 0; j < 4; ++j) { const int tt = t0 + t - 3 + j; if (tt >= 0) { const bf16* zr = FWS(bf16, WS_Z) + ((size_t)b * SEQ + tt) * ZP;
                aq += bf2f(zr[ZQM + h * 128 + d]) * cw[j * 1024 + h * 128 + d]; ak += bf2f(zr[ZKM + h * 128 + d]) * cw[j * 1024 + 512 + h * 128 + d]; } }
            Qs[t * MLP + d] = aq / (1.0f + __expf(-aq)); Ks[t * MLP + d] = ak / (1.0f + __expf(-ak)) * kscale;
            Vs[t * MLP + d] = bf2f(FWS(bf16, WS_Z)[(rowb + t) * ZP + ZVM + h * 128 + d]); }
        if (tid < 64) { const float ip = FWS(float, WS_GATES)[(rowb + tid) * 8 + h] + bi, fp = FWS(float, WS_GATES)[(rowb + tid) * 8 + 4 + h] + bfg;
            sc_ii[tid] = ip; sc_bc[tid] = fminf(fp, 0.f) - log1pf(__expf(-fabsf(fp))); }
        __syncthreads();
        if (tid == 0) { const float mst = sc_misc[0]; float cum = 0.f, amax = -INFINITY;
#pragma unroll 1
            for (int t = 0; t < 64; ++t) { cum += sc_bc[t]; sc_bc[t] = cum; amax = fmaxf(amax, sc_ii[t] - cum); const float inter = cum + mst; const float mt = fmaxf(inter, cum + amax);
                sc_mt[t] = mt; sc_wi[t] = __expf(inter - mt); }
            const float blast = cum; float gmax = -INFINITY;
#pragma unroll 1
            for (int s = 0; s < 64; ++s) gmax = fmaxf(gmax, blast - sc_bc[s] + sc_ii[s]);
            const float mnew = fmaxf(blast + mst, gmax);
#pragma unroll 1
            for (int s = 0; s < 64; ++s) sc_ws[s] = __expf(blast - sc_bc[s] + sc_ii[s] - mnew);
            sc_misc[1] = __expf(blast + mst - mnew); sc_misc[2] = mnew; }
        __syncthreads();
#pragma unroll 1
        for (int idx = tid; idx < 64 * 64; idx += 512) { const int t = idx >> 6, s = idx & 63; float v = 0.f;
            if (s <= t) { const LAS f32x4* qp = (const LAS f32x4*)(Qs + t * MLP); const LAS f32x4* kp = (const LAS f32x4*)(Ks + s * MLP); float d0 = 0.f;
#pragma unroll 8
                for (int d = 0; d < 32; ++d) { const f32x4 a = qp[d], k = kp[d]; d0 += a.x * k.x + a.y * k.y + a.z * k.z + a.w * k.w; }
                v = d0 * __expf(sc_bc[t] - sc_bc[s] + sc_ii[s] - sc_mt[t]); }
            Ss[t * 65 + s] = v; }
        __syncthreads();
        if (tid < 64) { const int t = tid; float den = 0.f;
#pragma unroll 4
            for (int s = 0; s < 64; ++s) den += Ss[t * 65 + s];
            float qn = 0.f;
#pragma unroll 4
            for (int d = 0; d < 128; ++d) qn += Qs[t * MLP + d] * nvec[d];
            den += sc_wi[t] * qn; sc_rd[t] = 1.0f / fmaxf(fabsf(den), __expf(-sc_mt[t])); }
#pragma unroll 1
        for (int t = 0; t < 64; ++t) { const LAS f32x4* qp = (const LAS f32x4*)(Qs + t * MLP + 32 * dq); float p = 0.f;
#pragma unroll
            for (int i = 0; i < 8; ++i) { const f32x4 a = qp[i]; p += a.x * C[4 * i] + a.y * C[4 * i + 1] + a.z * C[4 * i + 2] + a.w * C[4 * i + 3]; }
            p += __shfl_xor(p, 1); p += __shfl_xor(p, 2);
            if ((t & 3) == dq) HI[t * MLP + e] = p; }
        __syncthreads();
#pragma unroll 1
        for (int j = 0; j < 16; ++j) { const int t = 4 * j + dq; float a = 0.f;
#pragma unroll 4
            for (int s2 = 0; s2 < 64; ++s2) a += Ss[t * 65 + s2] * Vs[s2 * MLP + e];
            Hs[t * MLP + e] = (a + sc_wi[t] * HI[t * MLP + e]) * sc_rd[t]; }
        __syncthreads();
#pragma unroll 1
        for (int rr = 0; rr < 8; ++rr) { const int t = wave * 8 + rr; const float h0 = Hs[t * MLP + lane], h1 = Hs[t * MLP + 64 + lane];
            const float ss = wave_sum(h0 * h0 + h1 * h1); const float rs = rsqrtf(ss * (1.0f / 128.0f) + HEAD_EPS);
            const bf16* zr = FWS(bf16, WS_Z) + (rowb + t) * ZP + ZOM + h * 128; const float o0 = bf2f(zr[lane]), o1 = bf2f(zr[64 + lane]);
            const float y0 = h0 * rs * FIN(6)[l * 512 + h * 128 + lane] / (1.0f + __expf(-o0)), y1 = h1 * rs * FIN(6)[l * 512 + h * 128 + 64 + lane] / (1.0f + __expf(-o1));
            bf16* mo = FWS(bf16, WS_MIX) + (rowb + t) * DM + h * 128; mo[lane] = (bf16)(pg8::cvt_pk_bf16(y0, 0.f) & 0xffffu); mo[64 + lane] = (bf16)(pg8::cvt_pk_bf16(y1, 0.f) & 0xffffu); }
        { const float decay = sc_misc[1];
#pragma unroll
          for (int i = 0; i < 32; ++i) C[i] *= decay;
#pragma unroll 2
          for (int s = 0; s < 64; ++s) { const float ve = sc_ws[s] * Vs[s * MLP + e]; const LAS f32x4* kp = (const LAS f32x4*)(Ks + s * MLP + 32 * dq);
#pragma unroll
              for (int i = 0; i < 8; ++i) { const f32x4 k = kp[i]; C[4 * i] += ve * k.x; C[4 * i + 1] += ve * k.y; C[4 * i + 2] += ve * k.z; C[4 * i + 3] += ve * k.w; } }
          if (tid < 128) { float nn = decay * nvec[tid];
#pragma unroll 4
              for (int s = 0; s < 64; ++s) nn += sc_ws[s] * Ks[s * MLP + tid]; nvec[tid] = nn; }
          if (tid == 0) sc_misc[0] = sc_misc[2]; }
        __syncthreads();
    }
}


__global__ void __launch_bounds__(512) k_mlstm_naive(Args args, int l) {
    extern __shared__ __attribute__((aligned(16))) unsigned char lds[];
    Frame F; frame_init(F, args, lds);
    mlstm_naive_unit(F, l, (int)blockIdx.x >> 2, (int)blockIdx.x & 3);
}
__global__ void __launch_bounds__(512) k_attn_naive(Args args, int l) {
    extern __shared__ __attribute__((aligned(16))) unsigned char lds[];
    Frame F; frame_init(F, args, lds);
    const float lam_init = (l == 0) ? 0.20000000000000007f : (l == 1) ? 0.35550906759096934f : (l == 2) ? 0.4707130183435842f : 0.5560582041556406f;
    const float lam = layer_lambda(F, l, lam_init);
    const int u = (int)blockIdx.x; const int qb = 15 - (u >> 6), bh = u & 63;
    attn_naive_unit(F, l, bh >> 2, bh & 3, qb, lam, lam_init);
}

__device__ __forceinline__ void final_norm(Frame& F) {
    PHASE_TID();
    const int gw = F.vcu * NWAVES + wave, NGW = F.G * NWAVES;
    f32x4 g[4];
#pragma unroll
    for (int j = 0; j < 4; ++j) g[j] = ((const GAS f32x4*)FIN(17))[2 * lane + (j & 1) + 128 * (j >> 1)];
    for (int m = gw; m < M; m += NGW) {
        const bf16* xr = FWS(bf16, WS_XB) + (size_t)m * DM;
        float v[16]; { const v4u a = *(const GAS v4u*)(xr + 8 * lane), b = *(const GAS v4u*)(xr + 512 + 8 * lane); unpack8(a, v); unpack8(b, v + 8); }
        float s = 0.f;
#pragma unroll
        for (int j = 0; j < 16; ++j) s += v[j] * v[j];
        const float rs = rsqrtf(wave_sum(s) * (1.0f / DM) + EPS);
        GAS f32x4* o = (GAS f32x4*)((F.a->out) + (size_t)m * DM);
#pragma unroll
        for (int j = 0; j < 4; ++j) { const f32x4 x = {v[4 * j], v[4 * j + 1], v[4 * j + 2], v[4 * j + 3]}; o[2 * lane + (j & 1) + 128 * (j >> 1)] = x * rs * g[j]; }
    }
}

__global__ void __launch_bounds__(NWAVES * 64, 2) trunk_fwd(Args args) {
    extern __shared__ __attribute__((aligned(16))) unsigned char lds[];
    Frame F; frame_init(F, args, lds);
    for (int u = threadIdx.x; u < (LDS_BYTES - LDSCTL_OFF) / 4; u += NWAVES * 64) ((LAS unsigned*)(F.lds + LDSCTL_OFF))[u] = 0u;
    __syncthreads();
#if MK_ONE_LAUNCH
    XcdBarrier bar = xcd_barrier_post((unsigned*)(FWS(gu32, WS_CTL) + CW_BAR), F.MISC + 8);
#define GRID_BAR() xcd_barrier(bar)
#else
#define GRID_BAR() do {} while (0)
#endif
    const int lo = args.ph_lo, hi = args.ph_hi;
#define IN(k) (lo <= (k) && (k) < hi)
#define BOTH(k) (IN(k) && IN((k) + 1))

    if (IN(0)) { p0_prologue(F); VM_WAIT(); __syncthreads(); if (BOTH(0)) GRID_BAR(); }
    if ((PROBE_DUP & 1) && IN(0)) { p0_prologue(F); VM_WAIT(); __syncthreads(); if (BOTH(0)) GRID_BAR(); }

    for (int l = 0; l < NL; ++l) {
        const int pb = 1 + 6 * l;
        const float lam_init = __uint_as_float((unsigned)__builtin_amdgcn_readfirstlane((int)__float_as_uint((l == 0) ? 0.20000000000000007f : (l == 1) ? 0.35550906759096934f : (l == 2) ? 0.4707130183435842f : 0.5560582041556406f)));
        for (int rep = 0; rep < ((PROBE_DUP & 2) ? 2 : 1); ++rep)
        if (IN(pb)) {
            gates_phase(F, l);
            pg8::Gemm g{FWS(bf16, WS_XB), FWS(bf16, WS_WIN) + (size_t)l * ZP * DM, M, ZP, DM}; pg8::StaticOrder S; S.init(M, ZP, F.G, (int)blockIdx.x);
            pg8::EpiIn E{FWS(bf16, WS_Z), ZP, stage_rstd(F, S), FWS(const _Float16, WS_COS), C2};
            pg8::gemm_phase<pg8::EpiIn, pg8::StaticOrder, true, true>(F.lds + RING_OFF, g, S, E);
            if (BOTH(pb)) GRID_BAR();
        }
#define MIXER_PHASE(rep) do { \
            const float lam = __uint_as_float((unsigned)__builtin_amdgcn_readfirstlane((int)__float_as_uint(layer_lambda(F, l, lam_init)))); \
            const attn_body::DiffParams P{(const attn_body::bf16*)FWS(bf16, WS_Z), (attn_body::bf16*)FWS(bf16, WS_MIX), FIN(11) + l * 512, lam, 1.0f - lam_init}; \
            if (!USE_NAIVE_MLSTM && (int)blockIdx.x < 64 * MLS_SEGS && F.a->mix_sel != 2 && !((rep) == 1 && (PROBE_DUP & 32))) { \
                const int mseg = (int)blockIdx.x >> 6, mbh = (int)blockIdx.x & 63, mcb = (mseg == 0) ? 0 : MLS_SPLIT, mce = (MLS_SEGS == 1 || mseg == 1) ? 32 : MLS_SPLIT; \
                const mls::Params MP{(const unsigned short*)FWS(bf16, WS_Z), (const unsigned short*)(F.a->out), (unsigned short*)FWS(bf16, WS_MIX), FWS(float, WS_SCALX) + (size_t)blockIdx.x * SEQ * 4, FWS(float, WS_CHT), FWS(float, WS_GATES), FIN(3) + (size_t)l * 4096, FIN(4) + (size_t)l * 1024, FIN(5) + l * 8, FIN(6) + l * 512}; \
                if (PROBE_MLS_VAR != 0 && (rep) == 1) { mls::Params MP2 = MP; MP2.MIX = (unsigned short*)(F.a->out) + (size_t)M * 1024; mls::unit<PROBE_MLS_VAR>(MP2, mbh >> 2, mbh & 3, F.lds + RING_OFF, mcb, mce); } else \
                mls::unit<0>(MP, mbh >> 2, mbh & 3, F.lds + RING_OFF, mcb, mce); \
            } \
            if (F.a->mix_sel != 1 && !((rep) == 1 && (PROBE_DUP & 16))) attn_body::diffattn_queue<8>((char*)lds + RING_OFF, P, (unsigned*)(FWS(gu32, WS_CTL) + CW_QUEUE + ((rep) * NL + l) * 8 * 64), F.MISC + 16); \
            if (BOTH(pb + 2)) GRID_BAR(); \
        } while (0)
        if (IN(pb + 2)) { MIXER_PHASE(0); if (PROBE_DUP & (4 | 16 | 32)) MIXER_PHASE(1); }
#undef MIXER_PHASE
        if (IN(pb + 3)) {
            pg8::Gemm g{FWS(bf16, WS_MIX), FWS(bf16, WS_WOUT) + (size_t)l * DM * DM, M, DM, DM}; pg8::StaticOrder S; S.init(M, DM, F.G, (int)blockIdx.x);
            pg8::EpiRes E{FWS(bf16, WS_XB), FWS(float, WS_ROWSS)};
            pg8::gemm_phase<pg8::EpiRes, pg8::StaticOrder, true, true>(F.lds + RING_OFF, g, S, E);
            if (BOTH(pb + 3)) GRID_BAR();
        }
        for (int rep = 0; rep < ((PROBE_DUP & 8) ? 2 : 1); ++rep)
        if (IN(pb + 4)) {
            pg8::Gemm g{FWS(bf16, WS_XB), FWS(bf16, WS_WGU) + (size_t)l * NGU * DM, M, NGU, DM}; pg8::StaticOrder S; S.init(M, NGU, F.G, (int)blockIdx.x);
#if (PROBE_DUP & 256)
            { pg8::EpiGU<PROBE_GU_VAR> E2{FWS(bf16, WS_Z), FF, stage_rstd(F, S)}; pg8::gemm_phase<pg8::EpiGU<PROBE_GU_VAR>, pg8::StaticOrder, true, true>(F.lds + RING_OFF, g, S, E2); GRID_BAR(); }
#endif
            pg8::EpiGU<0> E{FWS(bf16, WS_Z), FF, stage_rstd(F, S)};
            pg8::gemm_phase<pg8::EpiGU<0>, pg8::StaticOrder, true, true>(F.lds + RING_OFF, g, S, E);
            if (BOTH(pb + 4)) GRID_BAR();
        }
        if (IN(pb + 5)) {
            pg8::Gemm g{FWS(bf16, WS_Z), FWS(bf16, WS_WDN) + (size_t)l * DM * FF, M, DM, FF}; pg8::ReverseOrder S; S.init(M, DM, F.G, (int)blockIdx.x);
            pg8::EpiRes E{FWS(bf16, WS_XB), FWS(float, WS_ROWSS)};
            pg8::gemm_phase<pg8::EpiRes, pg8::ReverseOrder, true, true>(F.lds + RING_OFF, g, S, E);
            if (BOTH(pb + 5)) GRID_BAR();
        }
    }
    if (IN(N_PHASES - 1)) final_norm(F);
#undef IN
#undef BOTH
}

extern "C" void kernel_launch(void* const* d_in, const int* in_sizes, int n_in, void* d_out, int out_size, void* d_ws, size_t ws_size, hipStream_t stream) {
    static int grid = 0;
    if (grid == 0) {
        if (n_in != 18 || out_size != M * DM || ws_size < WS_END) { fprintf(stderr, "kernel_launch: unexpected shapes (n_in %d, out %d, ws %zu, need %zu)\n", n_in, out_size, ws_size, (size_t)WS_END); grid = -1; return; }
        int dev = 0, cus = 0;
        if (hipGetDevice(&dev) != hipSuccess || hipDeviceGetAttribute(&cus, hipDeviceAttributeMultiprocessorCount, dev) != hipSuccess) { grid = -1; return; }
        if (hipFuncSetAttribute((const void*)trunk_fwd, hipFuncAttributeMaxDynamicSharedMemorySize, LDS_BYTES) != hipSuccess) { grid = -1; return; }
        if (hipFuncSetAttribute((const void*)k_mlstm_naive, hipFuncAttributeMaxDynamicSharedMemorySize, 160000) != hipSuccess || hipFuncSetAttribute((const void*)k_attn_naive, hipFuncAttributeMaxDynamicSharedMemorySize, 131072) != hipSuccess) { grid = -1; return; }
        int per_cu = 0;
        if (hipOccupancyMaxActiveBlocksPerMultiprocessor(&per_cu, (const void*)trunk_fwd, NWAVES * 64, LDS_BYTES) != hipSuccess || per_cu < 1) { fprintf(stderr, "kernel_launch: occupancy query says %d workgroups per CU; nothing launched\n", per_cu); grid = -1; return; }
        (void)hipGetLastError();
        if (cus < 256) { fprintf(stderr, "kernel_launch: built for a 256-CU device, found %d CUs; nothing launched\n", cus); grid = -1; return; }
        grid = 256;
    }
    if (grid < 0) return;
    (void)in_sizes;
    if (hipMemsetAsync((char*)d_ws + WS_CTL, 0, CTL_ZERO_BYTES, stream) != hipSuccess) return;
    Args a{};
    for (int i = 0; i < 18; ++i) a.in[i] = (const float*)d_in[i];
    a.out = (float*)d_out; a.ws = (unsigned char*)d_ws;
#if MK_ONE_LAUNCH
    a.ph_lo = 0; a.ph_hi = N_PHASES;
    hipLaunchKernelGGL(trunk_fwd, dim3(grid), dim3(NWAVES * 64), LDS_BYTES, stream, a);
#else
    for (int p = 0; p < N_PHASES; ++p) {
        if (p >= 1 && p < N_PHASES - 1 && (p - 1) % 6 == 2) { const int l = (p - 1) / 6;
            if (USE_NAIVE_MLSTM) hipLaunchKernelGGL(k_mlstm_naive, dim3(64), dim3(512), 160000, stream, a, l);
            if (USE_NAIVE_ATTN) { hipLaunchKernelGGL(k_attn_naive, dim3(1024), dim3(512), 131072, stream, a, l); continue; } }
        a.ph_lo = p; a.ph_hi = p + 1;
        if (SPLIT_MIXERS && p >= 1 && p < N_PHASES - 1 && (p - 1) % 6 == 2) { a.mix_sel = 1; hipLaunchKernelGGL(trunk_fwd, dim3(grid), dim3(NWAVES * 64), LDS_BYTES, stream, a); a.mix_sel = 2; hipLaunchKernelGGL(trunk_fwd, dim3(grid), dim3(NWAVES * 64), LDS_BYTES, stream, a); a.mix_sel = 0; continue; }
        hipLaunchKernelGGL(trunk_fwd, dim3(grid), dim3(NWAVES * 64), LDS_BYTES, stream, a); }
#endif
}
```

```cpp
#include <hip/hip_runtime.h>
#ifndef ATTN_ORDER
#define ATTN_ORDER 1
#endif
#include <cstdio>
#include <cstdint>
#include <cmath>
namespace pg8 {
#define PG8_LAS __attribute__((address_space(3)))
typedef unsigned short bf16_t;
typedef short bf16x8 __attribute__((ext_vector_type(8)));
typedef float f32x4 __attribute__((ext_vector_type(4)));
typedef unsigned u32x4 __attribute__((ext_vector_type(4)));
constexpr int BM = 256, BK = 64, HALF = 128, HTB = HALF * BK * 2  , STAGE_BYTES = 8 * HTB, NXCD = 8, WGM = 8;

__host__ __device__ __forceinline__ int lds_byte(int r, int c) { const int st = (r >> 4) * 2 + (c >> 5), rr = r & 15, cc = c & 31, ob = rr * 64 + cc * 2; return st * 1024 + (ob ^ (((ob >> 9) & 1) << 5)); }
__host__ __device__ __forceinline__ void stage_rc(int b, int& R, int& C) { const int st = b / 1024, sb = b % 1024, swz = sb ^ (((sb >> 9) & 1) << 5); R = (st >> 1) * 16 + swz / 64; C = (st & 1) * 32 + (swz % 64) / 2; }
__host__ __device__ __forceinline__ int perm32(int rho) { const int n = rho >> 4, i = rho & 15; return 8 * (i >> 2) + 4 * n + (i & 3); }

struct Unit { int pm, pn; };
struct Gemm { const bf16_t* A; const bf16_t* Bt; int M, N, K; size_t ax; };

struct StaticOrder {
    int nM, nN, nwg, G, c;
    __host__ __device__ void init(int M, int N, int G_, int c_) { nM = M / BM; nN = N / BM; nwg = nM * nN; G = G_; c = c_; }
    __host__ __device__ bool next(int i, Unit& u) const {
        const long L = (long)i * G + c; if (L >= nwg) return false;
        int wgid = (int)L; { const int q = nwg / NXCD, r = nwg % NXCD, xcd = wgid % NXCD, off = wgid / NXCD; wgid = (xcd < r ? xcd * (q + 1) : r * (q + 1) + (xcd - r) * q) + off; }
        const int nig = WGM * nN, gid = wgid / nig, fm = gid * WGM, gsz = (nM - fm) < WGM ? (nM - fm) : WGM;
        u.pm = fm + ((wgid % nig) % gsz); u.pn = (wgid % nig) / gsz; return true;
    }
    __device__ __forceinline__ void a_ready(const Unit&) const {}
    __device__ __forceinline__ void done(const Unit&) const {}
};

typedef float f32x2_c __attribute__((ext_vector_type(2))); typedef __bf16 bf16x2_c __attribute__((ext_vector_type(2)));
__device__ __forceinline__ unsigned cvt_pk_bf16(float lo, float hi) { f32x2_c v = {lo, hi}; bf16x2_c b = __builtin_convertvector(v, bf16x2_c); return __builtin_bit_cast(unsigned, b); }
typedef float f32x2 __attribute__((ext_vector_type(2)));
struct ReverseOrder : StaticOrder {
    int nr;
    __host__ __device__ void init(int M, int N, int G_, int c_) { StaticOrder::init(M, N, G_, c_); nr = (nwg - c + G - 1) / G; }
    __host__ __device__ bool next(int i, Unit& u) const { return (i < nr) && StaticOrder::next(nr - 1 - i, u); }
};
constexpr int ROWSS_SLOTS = 16;
__device__ __forceinline__ float row_rstd(const float* rowss, int row, int fq, float eps) {
    const f32x4 q = *(const f32x4*)(rowss + (size_t)row * ROWSS_SLOTS + fq * 4);
    float s = (q[0] + q[1]) + (q[2] + q[3]);
    s += __shfl_xor(s, 16); s += __shfl_xor(s, 32);
    return __builtin_amdgcn_rsqf(s * (1.0f / 1024.0f) + eps);
}
struct RstdTab { const PG8_LAS float* tab; int pm0; __device__ __forceinline__ float get(int pm, int row_in_panel) const { return tab[((pm - pm0) >> 3) * BM + row_in_panel]; } };
typedef _Float16 f16x8 __attribute__((ext_vector_type(8)));
typedef float f32x8 __attribute__((ext_vector_type(8)));
struct EpiIn {
    static constexpr bool PERM = true, AFTER_DRAIN = false;
    bf16_t* Z; int ZP; RstdTab rt; const _Float16* rot  ; float qscale;
    __device__ __forceinline__ void operator()(const f32x4 (&acc)[2][2][4][2], const Unit& u, int wr, int wc, int fr, int fq) const {
        const int row0 = u.pm * BM + wr * 64 + fr;
        if (u.pn >= 8 && u.pn < 12) {
            const bool isq = u.pn < 10; const int tile = isq ? u.pn - 8 : u.pn - 10;
            const int head = 2 * tile + (wc >> 1), cm = wc & 1;
            const int colbase = (isq ? 2048 : 2560) + head * 128 + cm * 64 + 8 * fq;
            const float sc = isq ? qscale : 1.f;
#pragma unroll
            for (int ai = 0; ai < 2; ++ai) {
                f16x8 tc[4], ts[4];
#pragma unroll
                for (int m = 0; m < 4; ++m) { const int pos = (row0 + ai * HALF + m * 16) & 2047; const _Float16* tp = rot + ((size_t)pos * 4 + fq) * 16; tc[m] = *(const f16x8*)tp; ts[m] = *(const f16x8*)(tp + 8); }
#pragma unroll
                for (int m = 0; m < 4; ++m) {
                    const int row = row0 + ai * HALF + m * 16; const float rs = rt.get(u.pm, row - u.pm * BM) * sc;
                    const f32x8 cf = __builtin_convertvector(tc[m], f32x8), sf = __builtin_convertvector(ts[m], f32x8);
                    const f32x4 c0 = {cf[0], cf[1], cf[2], cf[3]}, c1 = {cf[4], cf[5], cf[6], cf[7]}, s0 = {sf[0], sf[1], sf[2], sf[3]}, s1 = {sf[4], sf[5], sf[6], sf[7]};
                    const f32x4 a0 = acc[ai][0][m][0] * rs, a1 = acc[ai][0][m][1] * rs, b0 = acc[ai][1][m][0] * rs, b1 = acc[ai][1][m][1] * rs;
                    const f32x4 o10 = a0 * c0 - b0 * s0, o11 = a1 * c1 - b1 * s1, o20 = b0 * c0 + a0 * s0, o21 = b1 * c1 + a1 * s1;
                    bf16_t* rowp = Z + (size_t)row * ZP + colbase;
                    u32x4 w; w.x = cvt_pk_bf16(o10[0], o10[1]); w.y = cvt_pk_bf16(o10[2], o10[3]); w.z = cvt_pk_bf16(o11[0], o11[1]); w.w = cvt_pk_bf16(o11[2], o11[3]);
                    *(u32x4*)rowp = w;
                    w.x = cvt_pk_bf16(o20[0], o20[1]); w.y = cvt_pk_bf16(o20[2], o20[3]); w.z = cvt_pk_bf16(o21[0], o21[1]); w.w = cvt_pk_bf16(o21[2], o21[3]);
                    *(u32x4*)(rowp + 32) = w;
                }
            }
        } else {
            const int col0 = u.pn * BM + wc * 32 + 8 * fq; const bool ogate = (u.pn == 6) || (u.pn == 7);
#pragma unroll
            for (int ai = 0; ai < 2; ++ai)
#pragma unroll
                for (int m = 0; m < 4; ++m) {
                    const int row = row0 + ai * HALF + m * 16; const float rs = rt.get(u.pm, row - u.pm * BM);
                    bf16_t* rowp = Z + (size_t)row * ZP + col0;
#pragma unroll
                    for (int bj = 0; bj < 2; ++bj) { f32x4 v0 = acc[ai][bj][m][0] * rs, v1 = acc[ai][bj][m][1] * rs;
                        if (ogate) {
                            const f32x4 t0 = v0 * -1.4426950408889634f, t1 = v1 * -1.4426950408889634f;
                            const f32x4 e0 = {__builtin_amdgcn_exp2f(t0[0]), __builtin_amdgcn_exp2f(t0[1]), __builtin_amdgcn_exp2f(t0[2]), __builtin_amdgcn_exp2f(t0[3])}, e1 = {__builtin_amdgcn_exp2f(t1[0]), __builtin_amdgcn_exp2f(t1[1]), __builtin_amdgcn_exp2f(t1[2]), __builtin_amdgcn_exp2f(t1[3])};
                            const f32x4 d0 = e0 + 1.0f, d1 = e1 + 1.0f;
                            v0 = (f32x4){__builtin_amdgcn_rcpf(d0[0]), __builtin_amdgcn_rcpf(d0[1]), __builtin_amdgcn_rcpf(d0[2]), __builtin_amdgcn_rcpf(d0[3])}; v1 = (f32x4){__builtin_amdgcn_rcpf(d1[0]), __builtin_amdgcn_rcpf(d1[1]), __builtin_amdgcn_rcpf(d1[2]), __builtin_amdgcn_rcpf(d1[3])}; }
                        u32x4 w; w.x = cvt_pk_bf16(v0[0], v0[1]); w.y = cvt_pk_bf16(v0[2], v0[3]); w.z = cvt_pk_bf16(v1[0], v1[1]); w.w = cvt_pk_bf16(v1[2], v1[3]);
                        *(u32x4*)(rowp + bj * HALF) = w; }
                }
        }
    }
};
template <int NORSTD = 0> struct EpiGU {
    static constexpr bool PERM = true, AFTER_DRAIN = false;
    bf16_t* H; int HP; RstdTab rt; size_t hx;
    __device__ __forceinline__ void operator()(const f32x4 (&acc)[2][2][4][2], const Unit& u, int wr, int wc, int fr, int fq) const {
        const int row0 = u.pm * BM + wr * 64 + fr; const int col0 = u.pn * HALF + wc * 32 + 8 * fq;
        if (NORSTD == 2) {
#pragma unroll
            for (int ai = 0; ai < 2; ++ai)
#pragma unroll
                for (int bj = 0; bj < 2; ++bj)
#pragma unroll
                    for (int m = 0; m < 4; ++m) asm volatile("" :: "v"(acc[ai][bj][m][0]), "v"(acc[ai][bj][m][1]));
            return; }
#pragma unroll
        for (int ai = 0; ai < 2; ++ai)
#pragma unroll
            for (int m = 0; m < 4; ++m) {
                const int row = row0 + ai * HALF + m * 16; const float rs = NORSTD ? 1.0f : rt.get(u.pm, row - u.pm * BM);
                f32x4 hv[2]; const float rsn = rs * -1.4426950408889634f, rs2 = rs * rs;
#pragma unroll
                for (int n = 0; n < 2; ++n) { const f32x4 a = acc[ai][0][m][n], b = acc[ai][1][m][n]; const f32x4 t = a * rsn;
                    const f32x4 e = {__builtin_amdgcn_exp2f(t[0]), __builtin_amdgcn_exp2f(t[1]), __builtin_amdgcn_exp2f(t[2]), __builtin_amdgcn_exp2f(t[3])};
                    const f32x4 d = e + 1.0f; const f32x4 r = {__builtin_amdgcn_rcpf(d[0]), __builtin_amdgcn_rcpf(d[1]), __builtin_amdgcn_rcpf(d[2]), __builtin_amdgcn_rcpf(d[3])};
                    hv[n] = ((a * b) * rs2) * r; }
                u32x4 w; w.x = cvt_pk_bf16(hv[0][0], hv[0][1]); w.y = cvt_pk_bf16(hv[0][2], hv[0][3]); w.z = cvt_pk_bf16(hv[1][0], hv[1][1]); w.w = cvt_pk_bf16(hv[1][2], hv[1][3]);
                *(u32x4*)(H + (size_t)row * HP + (size_t)(row >> 12) * hx + col0) = w;
            }
    }
};
struct EpiRes {
    static constexpr bool PERM = true, AFTER_DRAIN = false;
    bf16_t* xb; float* rowss;
    __device__ __forceinline__ void operator()(const f32x4 (&acc)[2][2][4][2], const Unit& u, int wr, int wc, int fr, int fq) const {
        const int row0 = u.pm * BM + wr * 64 + fr; const int col0 = u.pn * BM + wc * 32 + 8 * fq;
#pragma unroll
        for (int ai = 0; ai < 2; ++ai) {
        u32x4 rres[4][2];
#pragma unroll
            for (int m = 0; m < 4; ++m)
#pragma unroll
                for (int bj = 0; bj < 2; ++bj) rres[m][bj] = *(const u32x4*)(xb + (size_t)(row0 + ai * HALF + m * 16) * 1024 + col0 + bj * HALF);
#pragma unroll
            for (int m = 0; m < 4; ++m) {
                const int row = row0 + ai * HALF + m * 16; const size_t off = (size_t)row * 1024 + col0; float ss = 0.f;
#pragma unroll
                for (int bj = 0; bj < 2; ++bj) {
                    const u32x4 r = rres[m][bj];
                    const f32x4 r0 = {__uint_as_float(r.x << 16), __uint_as_float(r.x & 0xffff0000u), __uint_as_float(r.y << 16), __uint_as_float(r.y & 0xffff0000u)};
                    const f32x4 r1 = {__uint_as_float(r.z << 16), __uint_as_float(r.z & 0xffff0000u), __uint_as_float(r.w << 16), __uint_as_float(r.w & 0xffff0000u)};
                    const f32x4 v0 = r0 + acc[ai][bj][m][0], v1 = r1 + acc[ai][bj][m][1];
                    u32x4 w; w.x = cvt_pk_bf16(v0[0], v0[1]); w.y = cvt_pk_bf16(v0[2], v0[3]); w.z = cvt_pk_bf16(v1[0], v1[1]); w.w = cvt_pk_bf16(v1[2], v1[3]);
                    *(u32x4*)(xb + off + bj * HALF) = w;
                    ss += (v0[0] * v0[0] + v0[1] * v0[1]) + (v0[2] * v0[2] + v0[3] * v0[3]) + (v1[0] * v1[0] + v1[1] * v1[1]) + (v1[2] * v1[2] + v1[3] * v1[3]);
                }
                ss += __shfl_xor(ss, 16); ss += __shfl_xor(ss, 32);
                if (fq == 0) rowss[(size_t)row * ROWSS_SLOTS + u.pn * 4 + wc] = ss;
            }
        }
    }
};

template <class Epi, class Sched, bool ALIGN_EPI = false, bool SP2 = false>
__device__ __forceinline__ void gemm_phase(PG8_LAS unsigned char* lds, const Gemm g, const Sched& S, const Epi& E) {
    int tid_ = threadIdx.x; asm volatile("" : "+v"(tid_));
    const int tid = tid_, wid = __builtin_amdgcn_readfirstlane(tid >> 6), lane = tid & 63, wr = wid >> 2, wc = wid & 3, fr = lane & 15, fq = lane >> 4;
    const int K = g.K, nt = K / BK;
    unsigned voffA[2], voffB[2];
#pragma unroll
    for (int i = 0; i < 2; ++i) { int R, C; stage_rc(tid * 16 + i * 8192, R, C); const int Rb = Epi::PERM ? ((R & ~31) + perm32(R & 31)) : R;
        voffA[i] = (unsigned)(R * K + C) * 2u; voffB[i] = (unsigned)(Rb * K + C) * 2u; }
    const size_t kstep = (size_t)(BK * 2);
    const size_t hstep = (size_t)HALF * K * 2;
    const size_t tstep = 2 * hstep;
    const unsigned ldsw = (unsigned)wid * 1024u;
    const int aoff = lds_byte(wr * 64 + fr, fq * 8), boff = lds_byte(wc * 32 + fr, fq * 8);
#define PG8_SA(b, h) (((b) * 2 + (h)) * HTB)
#define PG8_SB(b, h) ((4 + (b) * 2 + (h)) * HTB)
#define PG8_STAGE(bufoff, gbase, voff) do { _Pragma("unroll") for (int _i = 0; _i < 2; ++_i) \
        __builtin_amdgcn_global_load_lds((const unsigned*)((const char*)(gbase) + (voff)[_i]), (PG8_LAS unsigned*)(lds + (bufoff) + ldsw + _i * 8192), 16, 0, 0); } while (0)
#define PG8_LDA(dst, b, h) do { _Pragma("unroll") for (int m = 0; m < 4; ++m) _Pragma("unroll") for (int k = 0; k < 2; ++k) dst[m][k] = *(const PG8_LAS bf16x8*)(lds + PG8_SA(b, h) + aoff + m * 2048 + k * 1024); } while (0)
#define PG8_LDB(dst, b, h) do { _Pragma("unroll") for (int n = 0; n < 2; ++n) _Pragma("unroll") for (int k = 0; k < 2; ++k) dst[n][k] = *(const PG8_LAS bf16x8*)(lds + PG8_SB(b, h) + boff + n * 2048 + k * 1024); } while (0)
#define PG8_MMA(ai, bj, At, Bt) do { __builtin_amdgcn_s_setprio(1); _Pragma("unroll") for (int m = 0; m < 4; ++m) _Pragma("unroll") for (int n = 0; n < 2; ++n) _Pragma("unroll") for (int k = 0; k < 2; ++k) \
        acc[ai][bj][m][n] = __builtin_amdgcn_mfma_f32_16x16x32_bf16(Bt[n][k], At[m][k], acc[ai][bj][m][n], 0, 0, 0); __builtin_amdgcn_s_setprio(0); } while (0)
#define PG8_WAIT_V(n) asm volatile("s_waitcnt vmcnt(" #n ")" ::: "memory")
#define PG8_WAIT_L(n) asm volatile("s_waitcnt lgkmcnt(" #n ")" ::: "memory")
#define PG8_BAR __builtin_amdgcn_s_barrier()
#define PG8_SCHED __builtin_amdgcn_sched_barrier(0)
    Unit cur, nxt; int ui = 0;
    if (!S.next(0, cur)) return;
    f32x4 acc[2][2][4][2];
#pragma unroll
    for (int a = 0; a < 2; ++a)
#pragma unroll
        for (int b = 0; b < 2; ++b)
#pragma unroll
            for (int m = 0; m < 4; ++m)
#pragma unroll
                for (int n = 0; n < 2; ++n) acc[a][b][m][n] = (f32x4){0.f, 0.f, 0.f, 0.f};
    bf16x8 At[4][2], B0[2][2], B1[2][2];
    const char* cA = (const char*)g.A + (size_t)cur.pm * tstep + (size_t)(cur.pm >> 4) * g.ax; const char* cB = (const char*)g.Bt + (size_t)cur.pn * tstep;
    S.a_ready(cur);
    if constexpr (SP2) {
        PG8_STAGE(PG8_SB(0, 0), cB, voffB); PG8_STAGE(PG8_SB(0, 1), cB + hstep, voffB); PG8_STAGE(PG8_SA(0, 0), cA, voffA); PG8_STAGE(PG8_SA(0, 1), cA + hstep, voffA);
        if (wr == 1) PG8_BAR;
        PG8_WAIT_V(2); PG8_BAR;
        PG8_STAGE(PG8_SB(1, 0), cB + kstep, voffB); PG8_STAGE(PG8_SA(1, 0), cA + kstep, voffA); PG8_STAGE(PG8_SB(1, 1), cB + hstep + kstep, voffB);
        PG8_WAIT_V(6); PG8_BAR;
    } else {
        PG8_STAGE(PG8_SB(0, 0), cB, voffB); PG8_STAGE(PG8_SA(0, 0), cA, voffA); PG8_STAGE(PG8_SB(0, 1), cB + hstep, voffB); PG8_STAGE(PG8_SA(0, 1), cA + hstep, voffA);
        if (wr == 1) PG8_BAR;
        PG8_WAIT_V(4); PG8_BAR;
        PG8_STAGE(PG8_SB(1, 0), cB + kstep, voffB); PG8_STAGE(PG8_SA(1, 0), cA + kstep, voffA); PG8_STAGE(PG8_SB(1, 1), cB + hstep + kstep, voffB);
        PG8_WAIT_V(6); PG8_BAR;
    }
    for (;;) {
        const bool has_next = S.next(ui + 1, nxt);
        const char* nA = has_next ? (const char*)g.A + (size_t)nxt.pm * tstep + (size_t)(nxt.pm >> 4) * g.ax : cA; const char* nB = has_next ? (const char*)g.Bt + (size_t)nxt.pn * tstep : cB;
        for (int t = 0; t < nt; t += 2) {
            const bool last = (t == nt - 2);
            const char* a1 = cA + (size_t)(t + 1) * kstep;
            const char* a2 = last ? nA : cA + (size_t)(t + 2) * kstep; const char* b2 = last ? nB : cB + (size_t)(t + 2) * kstep;
            const char* a3 = a2 + kstep; const char* b3 = b2 + kstep;
            if (last && has_next) S.a_ready(nxt);
            if constexpr (SP2) {
            PG8_LDB(B0, 0, 0); PG8_LDB(B1, 0, 1); PG8_SCHED; PG8_LDA(At, 0, 0); PG8_STAGE(PG8_SA(1, 1), a1 + hstep, voffA);
            PG8_WAIT_V(8); PG8_WAIT_L(0); PG8_BAR; PG8_MMA(0, 0, At, B0); PG8_MMA(0, 1, At, B1); PG8_BAR; PG8_SCHED;
            PG8_LDA(At, 0, 1); PG8_STAGE(PG8_SB(0, 0), b2, voffB); PG8_STAGE(PG8_SB(0, 1), b2 + hstep, voffB); PG8_STAGE(PG8_SA(0, 0), a2, voffA);
            PG8_WAIT_V(8); PG8_WAIT_L(0); PG8_BAR; PG8_MMA(1, 0, At, B0); PG8_MMA(1, 1, At, B1); PG8_BAR; PG8_SCHED;
            PG8_LDB(B0, 1, 0); PG8_LDB(B1, 1, 1); PG8_SCHED; PG8_LDA(At, 1, 0); PG8_STAGE(PG8_SA(0, 1), a2 + hstep, voffA);
            PG8_WAIT_V(8); PG8_WAIT_L(0); PG8_BAR; PG8_MMA(0, 0, At, B0); PG8_MMA(0, 1, At, B1); PG8_BAR; PG8_SCHED;
            PG8_LDA(At, 1, 1); PG8_STAGE(PG8_SB(1, 0), b3, voffB); PG8_STAGE(PG8_SB(1, 1), b3 + hstep, voffB); PG8_STAGE(PG8_SA(1, 0), a3, voffA);
            PG8_WAIT_V(8); PG8_WAIT_L(0); PG8_BAR; PG8_MMA(1, 0, At, B0); PG8_MMA(1, 1, At, B1); PG8_BAR; PG8_SCHED;
            } else {
            PG8_LDB(B0, 0, 0); PG8_SCHED; PG8_LDA(At, 0, 0); PG8_STAGE(PG8_SA(1, 1), a1 + hstep, voffA);
            PG8_WAIT_L(8); PG8_BAR; PG8_WAIT_L(0); PG8_MMA(0, 0, At, B0); PG8_BAR; PG8_SCHED;
            PG8_LDB(B1, 0, 1); PG8_STAGE(PG8_SB(0, 0), b2, voffB);
            PG8_BAR; PG8_WAIT_L(0); PG8_MMA(0, 1, At, B1); PG8_BAR;
            PG8_LDA(At, 0, 1); PG8_STAGE(PG8_SA(0, 0), a2, voffA);
            PG8_BAR; PG8_WAIT_L(0); PG8_MMA(1, 0, At, B0); PG8_BAR; PG8_SCHED;
            PG8_STAGE(PG8_SB(0, 1), b2 + hstep, voffB);
            PG8_WAIT_V(6); PG8_BAR; PG8_MMA(1, 1, At, B1); PG8_BAR;
            PG8_LDB(B0, 1, 0); PG8_SCHED; PG8_LDA(At, 1, 0); PG8_STAGE(PG8_SA(0, 1), a2 + hstep, voffA);
            PG8_WAIT_L(8); PG8_BAR; PG8_WAIT_L(0); PG8_MMA(0, 0, At, B0); PG8_BAR; PG8_SCHED;
            PG8_LDB(B1, 1, 1); PG8_STAGE(PG8_SB(1, 0), b3, voffB);
            PG8_BAR; PG8_WAIT_L(0); PG8_MMA(0, 1, At, B1); PG8_BAR;
            PG8_LDA(At, 1, 1); PG8_STAGE(PG8_SA(1, 0), a3, voffA);
            PG8_BAR; PG8_WAIT_L(0); PG8_MMA(1, 0, At, B0); PG8_BAR; PG8_SCHED;
            PG8_STAGE(PG8_SB(1, 1), b3 + hstep, voffB);
            PG8_WAIT_V(6); PG8_BAR; PG8_MMA(1, 1, At, B1); PG8_BAR;
            }
        }
        if constexpr (ALIGN_EPI) { if (wr == 0) PG8_BAR; }
        if constexpr (!Epi::AFTER_DRAIN) { E(acc, cur, wr, wc, fr, fq); S.done(cur); }
        if (!has_next) break;
#pragma unroll
        for (int a = 0; a < 2; ++a)
#pragma unroll
            for (int b = 0; b < 2; ++b)
#pragma unroll
                for (int m = 0; m < 4; ++m)
#pragma unroll
                    for (int n = 0; n < 2; ++n) acc[a][b][m][n] = (f32x4){0.f, 0.f, 0.f, 0.f};
        cur = nxt; cA = nA; cB = nB; ++ui;
        if constexpr (ALIGN_EPI) { if (wr == 1) PG8_BAR; }
    }
    PG8_WAIT_V(0);
    if constexpr (!ALIGN_EPI) { if (wr == 0) PG8_BAR; }
    PG8_BAR;
    if constexpr (Epi::AFTER_DRAIN) { E.fused(acc, cur, wr, wc, fr, fq, lds, wid, lane); S.done(cur); }
#undef PG8_SA
#undef PG8_SB
#undef PG8_STAGE
#undef PG8_LDA
#undef PG8_LDB
#undef PG8_MMA
#undef PG8_WAIT_V
#undef PG8_WAIT_L
#undef PG8_BAR
#undef PG8_SCHED
}
}
#define GAS __attribute__((address_space(1)))
#define LAS __attribute__((address_space(3)))
typedef unsigned short bf16;
typedef unsigned v4u __attribute__((ext_vector_type(4)));
typedef float f32x4 __attribute__((ext_vector_type(4)));
typedef short bf16x8 __attribute__((ext_vector_type(8)));
typedef GAS unsigned gu32;
typedef GAS unsigned long long gu64;
#define RLX_AGENT __ATOMIC_RELAXED, __HIP_MEMORY_SCOPE_AGENT
#define LDS_WAIT() asm volatile("s_waitcnt lgkmcnt(0)" ::: "memory")
#define VM_WAIT() asm volatile("s_waitcnt vmcnt(0)" ::: "memory")
__device__ __forceinline__ unsigned long long rt() { return __builtin_amdgcn_s_memrealtime(); }
__device__ __forceinline__ unsigned f2bf(float f) { unsigned u = __builtin_bit_cast(unsigned, f); return (u + 0x7fffu + ((u >> 16) & 1u)) >> 16; }
__device__ __forceinline__ unsigned pk2(float lo, float hi) { return f2bf(lo) | (f2bf(hi) << 16); }

#define XB_TMO      128
#define XB_XCNT(j)  (256  + 64 * (j))
#define XB_XSUB(j)  (1280 + 64 * (j))
#define XB_XGEN(j)  (2304 + 64 * (j))
#define XB_TOP      3328
#define XB_TOPGEN   3392
#define XCD_BAR_WORDS 3456
#define XB_SPIN_CAP (1u << 18)

__device__ __forceinline__ unsigned xb_ld(unsigned* p)              { return __hip_atomic_load(p, __ATOMIC_RELAXED, __HIP_MEMORY_SCOPE_AGENT); }
__device__ __forceinline__ unsigned xb_add(unsigned* p, unsigned v) { return __hip_atomic_fetch_add(p, v, __ATOMIC_RELAXED, __HIP_MEMORY_SCOPE_AGENT); }
__device__ __forceinline__ unsigned xb_xcc_id() { return (unsigned)__builtin_amdgcn_s_getreg((3 << 11) | 20) & 0xFu; }
#define XB_SPIN(cond, bar) do { unsigned _sp = 0; while (cond) { __builtin_amdgcn_s_sleep(1); \
    if ((++_sp & 255u) == 0u) { if (xb_ld(&(bar)[XB_TMO])) break; if (_sp > XB_SPIN_CAP) { atomicAdd(&(bar)[XB_TMO], 1u); break; } } } } while (0)

struct XcdBarrier {
    unsigned* bar; unsigned x;
    volatile LAS unsigned* st;
};

__device__ __forceinline__ XcdBarrier xcd_barrier_post(unsigned* bar, volatile LAS unsigned* st) {
    XcdBarrier b; b.bar = bar; b.x = xb_xcc_id(); b.st = st;
    if (threadIdx.x == 0) (void)xb_add(&bar[XB_XCNT(b.x)], 1u);
    return b;
}
__device__ __forceinline__ void xcd_barrier_complete(unsigned* bar, unsigned x, unsigned& nloc, unsigned& nx) {
    const unsigned G = gridDim.x * gridDim.y * gridDim.z;
    unsigned sum, cnt, mine, sp = 0u;
    for (;;) {
        sum = 0u; cnt = 0u; mine = 0u;
#pragma unroll
        for (unsigned j = 0; j < 16; ++j) { const unsigned c = xb_ld(&bar[XB_XCNT(j)]); sum += c; cnt += (c > 0u) ? 1u : 0u; mine = (j == x) ? c : mine; }
        if (sum == G) break;
        __builtin_amdgcn_s_sleep(1);
        if ((++sp & 255u) == 0u) { if (xb_ld(&bar[XB_TMO])) break; if (sp > XB_SPIN_CAP) { atomicAdd(&bar[XB_TMO], 1u); break; } }
    }
    nloc = mine > 0u ? mine : 1u; nx = cnt > 0u ? cnt : 1u;
}

#define XB_LSUB(j)  (3520 + 64 * (j))
#define XB_LGEN(j)  (3552 + 64 * (j))
__device__ __forceinline__ void xcd_local_barrier(const XcdBarrier& b) {
    asm volatile("s_waitcnt vmcnt(0)" ::: "memory");
    __syncthreads();
    if (threadIdx.x == 0) {
        unsigned* bar = b.bar;
        __builtin_amdgcn_s_waitcnt(0);
        const unsigned old = xb_add(&bar[XB_LSUB(b.x)], 1u); const unsigned gen = old / 32u;
        if (old + 1u == (gen + 1u) * 32u) xb_add(&bar[XB_LGEN(b.x)], 1u);
        else XB_SPIN(xb_ld(&bar[XB_LGEN(b.x)]) == gen, bar);
        __builtin_amdgcn_fence(__ATOMIC_ACQUIRE, "agent");
        asm volatile("s_waitcnt vmcnt(0)" ::: "memory");
    }
    __syncthreads();
}
template <bool LIGHT = false> __device__ __forceinline__ void xcd_barrier(const XcdBarrier& b) {
    asm volatile("s_waitcnt vmcnt(0)" ::: "memory");
    __syncthreads();
    if (threadIdx.x == 0) {
        unsigned* bar = b.bar;
        __builtin_amdgcn_s_waitcnt(0);
        unsigned nloc = b.st[0], nx = b.st[1];
        if (nloc == 0u) { xcd_barrier_complete(bar, b.x, nloc, nx); b.st[0] = nloc; b.st[1] = nx; }
        const unsigned old = xb_add(&bar[XB_XSUB(b.x)], 1u);
        const unsigned gen = old / nloc;
        if (old + 1u == (gen + 1u) * nloc) {
            if (!LIGHT) __builtin_amdgcn_fence(__ATOMIC_RELEASE, "agent");
            asm volatile("s_waitcnt vmcnt(0)" ::: "memory");
            const unsigned og = xb_add(&bar[XB_TOP], 1u);
            const unsigned tg = og / nx;
            if (og + 1u == (tg + 1u) * nx) xb_add(&bar[XB_TOPGEN], 1u);
            else XB_SPIN(xb_ld(&bar[XB_TOPGEN]) == tg, bar);
            __builtin_amdgcn_fence(__ATOMIC_ACQUIRE, "agent");
            xb_add(&bar[XB_XGEN(b.x)], 1u);
            asm volatile("s_waitcnt vmcnt(0)" ::: "memory");
        } else {
            XB_SPIN(xb_ld(&bar[XB_XGEN(b.x)]) == gen, bar);
            __builtin_amdgcn_fence(__ATOMIC_ACQUIRE, "agent");
            asm volatile("s_waitcnt vmcnt(0)" ::: "memory");
        }
    }
    __syncthreads();
}
#include <hip/hip_bf16.h>
#include <cmath>
namespace attn_body {
using bf16=__hip_bfloat16;
using bf16x8=__attribute__((ext_vector_type(8)))short;
using s16x4=__attribute__((ext_vector_type(4)))short;
using f32x16=__attribute__((ext_vector_type(16)))float;
using u32x4=__attribute__((ext_vector_type(4)))unsigned;
constexpr int SEQ=2048,D=64,DM=3584;
constexpr int NW=8,QBLK=32,QB=QBLK*NW,KVBLK=64,NQB=SEQ/QB;
__device__ __forceinline__ int crow(int r,int hi){return (r&3)+8*(r>>2)+4*hi;}
#define SBAR() __builtin_amdgcn_sched_barrier(0)
__device__ __forceinline__ void cmask(f32x16&p0,f32x16&p1,int jb,int qrel,int hi){
  const float NEG=-INFINITY; int kb=64*jb+4*hi;
  #pragma unroll
  for(int r=0;r<16;++r){int kv=kb+(r&3)+8*(r>>2); if(kv>qrel)p0[r]=NEG; if(kv+32>qrel)p1[r]=NEG;}
}

constexpr int NSLOT=3, SLOTB=8192;
constexpr int LDS_K=0, LDS_V=NSLOT*SLOTB, LDS_WS=3*NSLOT*SLOTB, LDS_ST=LDS_WS+NW*64*4, LDS_BYTES=LDS_ST+NW*8192;
constexpr float C2=0.125f*1.4426950408889634f;
__device__ __forceinline__ void glds16(const void*gsrc,unsigned lds_dst){unsigned keep;
  asm volatile("s_mov_b32 %0, m0\n\ts_mov_b32 m0, %2\n\ts_nop 0\n\tglobal_load_lds_dwordx4 %1, off\n\ts_mov_b32 m0, %0":"=&s"(keep):"v"(gsrc),"s"(lds_dst):"memory");}
__device__ __forceinline__ float max3f(float a,float b,float c){float r;asm("v_max3_f32 %0, %1, %2, %3":"=v"(r):"v"(a),"v"(b),"v"(c));return r;}
__device__ __forceinline__ float max2f(float a,float b){float r;asm("v_max_f32_e32 %0, %1, %2":"=v"(r):"v"(a),"v"(b));return r;}
__device__ __forceinline__ float fadd_s(float a,float b){float r;asm("v_add_f32_e32 %0, %1, %2":"=v"(r):"v"(a),"v"(b));return r;}
__device__ __forceinline__ float fsub_s(float a,float b){float r;asm("v_sub_f32_e32 %0, %1, %2":"=v"(r):"v"(a),"v"(b));return r;}
typedef float f32x2_t __attribute__((ext_vector_type(2))); typedef __bf16 bf16x2_t __attribute__((ext_vector_type(2)));
__device__ __forceinline__ unsigned cvtpk_s(float lo,float hi){f32x2_t v={lo,hi};bf16x2_t b=__builtin_convertvector(v,bf16x2_t);return __builtin_bit_cast(unsigned,b);}
#define WAIT_BAR(N) asm volatile("s_waitcnt vmcnt(" #N ") lgkmcnt(0)\n\ts_barrier":::"memory")

__device__ __forceinline__ void qkt(f32x16&p0,f32x16&p1,const char*Kslot,const bf16x8*qr,const f32x16&negm,int r32,int hi){
  const char*kb=Kslot+hi*1024+r32*16;
  #pragma unroll
  for(int d0=0;d0<4;++d0){
    const bf16x8 b0=*reinterpret_cast<const bf16x8*>(kb+d0*2048);
    const bf16x8 b1=*reinterpret_cast<const bf16x8*>(kb+d0*2048+512);
    if(d0==0){p0=__builtin_amdgcn_mfma_f32_32x32x16_bf16(b0,qr[0],negm,0,0,0);p1=__builtin_amdgcn_mfma_f32_32x32x16_bf16(b1,qr[0],negm,0,0,0);}
    else{p0=__builtin_amdgcn_mfma_f32_32x32x16_bf16(b0,qr[d0],p0,0,0,0);p1=__builtin_amdgcn_mfma_f32_32x32x16_bf16(b1,qr[d0],p1,0,0,0);}}
}
typedef __attribute__((address_space(3))) const char* lds_cptr;
typedef short v4i16_t __attribute__((ext_vector_type(4)));
__device__ __forceinline__ void kload8(bf16x8*kf,lds_cptr kp){
  kf[0]=*(const __attribute__((address_space(3))) bf16x8*)(kp);      kf[1]=*(const __attribute__((address_space(3))) bf16x8*)(kp+512);
  kf[2]=*(const __attribute__((address_space(3))) bf16x8*)(kp+2048); kf[3]=*(const __attribute__((address_space(3))) bf16x8*)(kp+2560);
  kf[4]=*(const __attribute__((address_space(3))) bf16x8*)(kp+4096); kf[5]=*(const __attribute__((address_space(3))) bf16x8*)(kp+4608);
  kf[6]=*(const __attribute__((address_space(3))) bf16x8*)(kp+6144); kf[7]=*(const __attribute__((address_space(3))) bf16x8*)(kp+6656);
}
__device__ __forceinline__ void kload2(bf16x8*kf,lds_cptr kp,int j){ kf[2*j]=*(const __attribute__((address_space(3))) bf16x8*)(kp+j*2048); kf[2*j+1]=*(const __attribute__((address_space(3))) bf16x8*)(kp+j*2048+512); }
__device__ __forceinline__ s16x4 vtr(lds_cptr p){ return __builtin_bit_cast(s16x4,__builtin_amdgcn_ds_read_tr16_b64_v4i16((__attribute__((address_space(3))) v4i16_t*)p)); }
__device__ __forceinline__ float rowmax(const f32x16&p0,const f32x16&p1){
  float a=max3f(p0[0],p0[1],p1[0]),b=max3f(p0[2],p0[3],p1[1]);a=max3f(a,p1[2],p1[3]);
  #pragma unroll
  for(int r=4;r<16;r+=4){a=max3f(a,p0[r],p0[r+1]);b=max3f(b,p0[r+2],p0[r+3]);a=max3f(a,p1[r],p1[r+1]);b=max3f(b,p1[r+2],p1[r+3]);}
  const float m=max2f(a,b);
  auto rr=__builtin_amdgcn_permlane32_swap(__float_as_uint(m),__float_as_uint(m),false,false);
  return max2f(__uint_as_float(rr[0]),__uint_as_float(rr[1]));
}
__device__ __forceinline__ void pv(f32x16*o,int vb,bf16x8 pa0,bf16x8 pa1,bf16x8 pa2,bf16x8 pa3){
  #pragma unroll
  for(int d0=0;d0<4;++d0){s16x4 lo[4],hi[4];
    #pragma unroll
    for(int ks=0;ks<4;++ks){
      asm volatile("ds_read_b64_tr_b16 %0,%1 offset:%c2":"=&v"(lo[ks]):"v"(vb),"i"(d0*4096+ks*1024):"memory");
      asm volatile("ds_read_b64_tr_b16 %0,%1 offset:%c2":"=&v"(hi[ks]):"v"(vb),"i"(d0*4096+ks*1024+512):"memory");}
    asm volatile("s_waitcnt lgkmcnt(0)":::"memory");SBAR();
    #define PK(k) (bf16x8){lo[k][0],lo[k][1],lo[k][2],lo[k][3],hi[k][0],hi[k][1],hi[k][2],hi[k][3]}
    o[d0]=__builtin_amdgcn_mfma_f32_32x32x16_bf16(pa0,PK(0),o[d0],0,0,0);
    o[d0]=__builtin_amdgcn_mfma_f32_32x32x16_bf16(pa1,PK(1),o[d0],0,0,0);
    o[d0]=__builtin_amdgcn_mfma_f32_32x32x16_bf16(pa2,PK(2),o[d0],0,0,0);
    o[d0]=__builtin_amdgcn_mfma_f32_32x32x16_bf16(pa3,PK(3),o[d0],0,0,0);
    #undef PK
  }
}

template<int THRL> __device__ __forceinline__ void attn_pass(const bf16*Qw,const bf16*__restrict__ Kh,const bf16*__restrict__ Vh,int q0,char*shm,f32x16(&o)[4],float&l_reg){
  int tid_=threadIdx.x; asm volatile("":"+v"(tid_)); const int tid=tid_,lane=tid&63,r32=lane&31,hi=lane>>5; const int wid=__builtin_amdgcn_readfirstlane(tid>>6);
  const unsigned lds0=(unsigned)(uintptr_t)shm;
  float*wsf=(float*)(shm+LDS_WS)+wid*64;
  const bf16*ksrc=Kh+(long)lane*DM+wid*8;
  const bf16*vsrc=Vh+(long)(16*(wid&3)+(lane>>2))*DM+(wid>>2)*32+(lane&3)*8;
  const unsigned kdst=lds0+LDS_K+wid*1024, vdst=lds0+LDS_V+wid*1024;
  #define DMA_K(t,slot) glds16(ksrc+(long)(t)*KVBLK*DM,(unsigned)__builtin_amdgcn_readfirstlane(kdst+(slot)))
  #define DMA_V(t,vslot) do{ glds16(vsrc+(long)(t)*KVBLK*DM,(unsigned)__builtin_amdgcn_readfirstlane(vdst+(vslot))); glds16(vsrc+(long)(t)*KVBLK*DM+64,(unsigned)__builtin_amdgcn_readfirstlane(vdst+(vslot)+8192)); }while(0)
  const int vb0=(int)(lds0+LDS_V)+((lane>>4)&1)*32+(lane&3)*8+(4*hi+((lane&15)>>2))*64;
  const char*Kbase=shm+LDS_K; bf16x8 kf[8];
  const lds_cptr shm3=(lds_cptr)shm; const lds_cptr kp0=shm3+LDS_K+hi*1024+r32*16; const lds_cptr vp0=shm3+LDS_V+((lane>>4)&1)*32+(lane&3)*8+(4*hi+((lane&15)>>2))*64;
  const int NT=(q0+QB)/KVBLK;
  DMA_K(0,0);DMA_V(0,0);DMA_K(1,SLOTB);
  bf16x8 qr[4];
  #pragma unroll
  for(int d0=0;d0<4;++d0)qr[d0]=*reinterpret_cast<const bf16x8*>(&Qw[(long)r32*DM+d0*16+hi*8]);
  float mhat=0.f;l_reg=0.f;o[0]=f32x16{};o[1]=f32x16{};o[2]=f32x16{};o[3]=f32x16{};f32x16 negm=f32x16{};asm volatile("":"+v"(negm));
  const int qrel=wid*QBLK+r32;
  #define CMASK(P0,P1,t) do{int jb_=(t)-(NT-4); if(jb_>=0)cmask(P0,P1,jb_,qrel,hi);}while(0)
  bool resc=false;
  #define START(P0,P1) do{ const float rm=rowmax(P0,P1); resc=false; \
    { const float dl=rm; mhat=fadd_s(mhat,dl); \
      _Pragma("unroll") for(int r=0;r<16;++r){P0[r]=fsub_s(P0[r],dl);P1[r]=fsub_s(P1[r],dl);} \
      _Pragma("unroll") for(int r=0;r<16;++r)negm[r]=-mhat; asm volatile("":"+v"(negm)); } \
    _Pragma("unroll") for(int r=0;r<16;++r)P0[r]=__builtin_amdgcn_exp2f(P0[r]); }while(0)
  #define RESC() do{ if(resc){ asm volatile("s_waitcnt lgkmcnt(0)":::"memory"); \
      _Pragma("unroll") for(int d_=0;d_<4;++d_) _Pragma("unroll") for(int r=0;r<16;++r)o[d_][r]*=wsf[crow(r,hi)]; } }while(0)
  f32x16 pA0,pA1,pB0,pB1;
  int sl_prev=0,sl_cur=0,sl_next=SLOTB;
  #define ROT() do{sl_prev=sl_cur;sl_cur=sl_next;sl_next=(sl_next==(NSLOT-1)*SLOTB)?0:sl_next+SLOTB;}while(0)
  DMA_K(2,2*SLOTB);
  WAIT_BAR(4);
  qkt(pA0,pA1,Kbase,qr,negm,r32,hi);asm volatile("s_nop 15\n\ts_nop 7":"+v"(pA0),"+v"(pA1));CMASK(pA0,pA1,0);
  START(pA0,pA1);
  _Pragma("unroll") for(int r=0;r<16;++r)pA1[r]=__builtin_amdgcn_exp2f(pA1[r]);
  WAIT_BAR(0);
  DMA_K(3,0);DMA_V(1,2*SLOTB);
  ROT();
  kload8(kf,kp0+sl_cur);
  WAIT_BAR(3);
  s16x4 vlo[8],vhi[8]; u32x4 pw0,pw1,pw2,pw3;
  #define PKW(P,B) cvtpk_s(P[B],P[B+1])
  #define PAF(k) __builtin_bit_cast(bf16x8,pw##k)
  #define VFR(i) (bf16x8){vlo[i][0],vlo[i][1],vlo[i][2],vlo[i][3],vhi[i][0],vhi[i][1],vhi[i][2],vhi[i][3]}
  #define PIN(x) asm volatile("":"+v"(x))
  #define MX3(a,b,c) __builtin_fmaxf(__builtin_fmaxf((a),(b)),(c))
  #define GAPA(MF,A0,A1,A2,A3,W0,W1,PW) do{ MF; sacc+=A0; sacc+=A1; sacc+=A2; sacc+=A3; PIN(sacc); W0; W1; PIN(PW); SBAR(); }while(0)
  #define EX(v) __builtin_amdgcn_exp2f(v)
  #define GAPB(MF,X,B) do{ MF; X[B]=EX(X[B]); X[B+1]=EX(X[B+1]); PIN(X); SBAR(); }while(0)
  #define VRD2(i) do{ vlo[i]=vtr(vp_+((2+((i)>>2))*4096+((i)&3)*1024)); vhi[i]=vtr(vp_+((2+((i)>>2))*4096+((i)&3)*1024+512)); SBAR(); }while(0)
  #define VRD(i) do{ vlo[i]=vtr(vp_+(((i)>>2)*4096+((i)&3)*1024)); vhi[i]=vtr(vp_+(((i)>>2)*4096+((i)&3)*1024+512)); }while(0)
  #define KRD(G,j) do{ if(G){ kload2(kf,kp0+sl_next,j); SBAR(); } }while(0)
  #define STEP(C0,C1,P0,P1,t,GK,GV,GL) do{ SBAR(); \
    const lds_cptr vp_=vp0+2*sl_prev; \
    VRD(0); SBAR(); float sacc=(P0[0]+P0[1]); \
    GAPA(C0=__builtin_amdgcn_mfma_f32_32x32x16_bf16(kf[0],qr[0],negm,0,0,0), P0[2],P0[3],P0[4],P0[5],     pw0[0]=PKW(P0,0), pw0[1]=PKW(P0,2), pw0); \
    VRD(4); SBAR(); GAPA(C1=__builtin_amdgcn_mfma_f32_32x32x16_bf16(kf[1],qr[0],negm,0,0,0), P0[6],P0[7],P0[8],P0[9],     pw0[2]=PKW(P0,4), pw0[3]=PKW(P0,6), pw0); \
    VRD(1); SBAR(); GAPA(C0=__builtin_amdgcn_mfma_f32_32x32x16_bf16(kf[2],qr[1],C0,0,0,0),   P0[10],P0[11],P0[12],P0[13], pw1[0]=PKW(P0,8), pw1[1]=PKW(P0,10), pw1); \
    VRD(5); SBAR(); GAPA(C1=__builtin_amdgcn_mfma_f32_32x32x16_bf16(kf[3],qr[1],C1,0,0,0),   P0[14],P0[15],P1[0],P1[1],   pw1[2]=PKW(P0,12),pw1[3]=PKW(P0,14), pw1); \
    VRD(2); SBAR(); GAPA(C0=__builtin_amdgcn_mfma_f32_32x32x16_bf16(kf[4],qr[2],C0,0,0,0),   P1[2],P1[3],P1[4],P1[5],     pw2[0]=PKW(P1,0), pw2[1]=PKW(P1,2), pw2); \
    VRD(6); SBAR(); GAPA(C1=__builtin_amdgcn_mfma_f32_32x32x16_bf16(kf[5],qr[2],C1,0,0,0),   P1[6],P1[7],P1[8],P1[9],     pw2[2]=PKW(P1,4), pw2[3]=PKW(P1,6), pw2); \
    VRD(3); SBAR(); GAPA(C0=__builtin_amdgcn_mfma_f32_32x32x16_bf16(kf[6],qr[3],C0,0,0,0),   P1[10],P1[11],P1[12],P1[13], pw3[0]=PKW(P1,8), pw3[1]=PKW(P1,10), pw3); \
    VRD(7); SBAR(); GAPA(C1=__builtin_amdgcn_mfma_f32_32x32x16_bf16(kf[7],qr[3],C1,0,0,0),   P1[14],P1[15],0.f,0.f,       pw3[2]=PKW(P1,12),pw3[3]=PKW(P1,14), pw3); \
    l_reg+=sacc; \
    if(GK){DMA_K((t)+3,sl_cur);} if(GV){DMA_V((t)+1,2*sl_next);} \
    CMASK(C0,C1,t); \
    { float a=MX3(C0[0],C0[1],C1[0]),b=MX3(C0[2],C0[3],C1[1]); a=MX3(a,C1[2],C1[3]); \
      _Pragma("unroll") for(int r=4;r<16;r+=4){a=MX3(a,C0[r],C0[r+1]);b=MX3(b,C0[r+2],C0[r+3]);a=MX3(a,C1[r],C1[r+1]);b=MX3(b,C1[r+2],C1[r+3]);} \
      float rm=__builtin_fmaxf(a,b); { auto rr=__builtin_amdgcn_permlane32_swap(__float_as_uint(rm),__float_as_uint(rm),false,false); rm=__builtin_fmaxf(__uint_as_float(rr[0]),__uint_as_float(rr[1])); } \
      resc=false; \
      if(__builtin_expect(__any(rm>(float)THRL),0)){ const float dl=__builtin_fmaxf(rm,0.f); mhat+=dl; \
        _Pragma("unroll") for(int r=0;r<16;++r){C0[r]-=dl;C1[r]-=dl;} \
        _Pragma("unroll") for(int r=0;r<16;++r)negm[r]=-mhat; asm volatile("":"+v"(negm)); \
        const float f=__builtin_amdgcn_exp2f(-dl); l_reg*=f; if(hi==0)wsf[r32]=f; resc=true; } } \
    SBAR(); \
    GAPB(o[0]=__builtin_amdgcn_mfma_f32_32x32x16_bf16(PAF(0),VFR(0),o[0],0,0,0), C0,0);  VRD2(0); \
    GAPB(o[1]=__builtin_amdgcn_mfma_f32_32x32x16_bf16(PAF(0),VFR(4),o[1],0,0,0), C0,2);  VRD2(4); \
    KRD(GL,0); GAPB(o[0]=__builtin_amdgcn_mfma_f32_32x32x16_bf16(PAF(1),VFR(1),o[0],0,0,0), C0,4);  VRD2(1); \
    KRD(GL,1); GAPB(o[1]=__builtin_amdgcn_mfma_f32_32x32x16_bf16(PAF(1),VFR(5),o[1],0,0,0), C0,6);  VRD2(5); \
    KRD(GL,2); GAPB(o[0]=__builtin_amdgcn_mfma_f32_32x32x16_bf16(PAF(2),VFR(2),o[0],0,0,0), C0,8);  VRD2(2); \
    KRD(GL,3); GAPB(o[1]=__builtin_amdgcn_mfma_f32_32x32x16_bf16(PAF(2),VFR(6),o[1],0,0,0), C0,10); VRD2(6); \
    GAPB(o[0]=__builtin_amdgcn_mfma_f32_32x32x16_bf16(PAF(3),VFR(3),o[0],0,0,0), C0,12); VRD2(3); \
    GAPB(o[1]=__builtin_amdgcn_mfma_f32_32x32x16_bf16(PAF(3),VFR(7),o[1],0,0,0), C0,14); VRD2(7); \
    GAPB(o[2]=__builtin_amdgcn_mfma_f32_32x32x16_bf16(PAF(0),VFR(0),o[2],0,0,0), C1,0); \
    GAPB(o[3]=__builtin_amdgcn_mfma_f32_32x32x16_bf16(PAF(0),VFR(4),o[3],0,0,0), C1,2); \
    GAPB(o[2]=__builtin_amdgcn_mfma_f32_32x32x16_bf16(PAF(1),VFR(1),o[2],0,0,0), C1,4); \
    GAPB(o[3]=__builtin_amdgcn_mfma_f32_32x32x16_bf16(PAF(1),VFR(5),o[3],0,0,0), C1,6); \
    GAPB(o[2]=__builtin_amdgcn_mfma_f32_32x32x16_bf16(PAF(2),VFR(2),o[2],0,0,0), C1,8); \
    GAPB(o[3]=__builtin_amdgcn_mfma_f32_32x32x16_bf16(PAF(2),VFR(6),o[3],0,0,0), C1,10); \
    GAPB(o[2]=__builtin_amdgcn_mfma_f32_32x32x16_bf16(PAF(3),VFR(3),o[2],0,0,0), C1,12); \
    GAPB(o[3]=__builtin_amdgcn_mfma_f32_32x32x16_bf16(PAF(3),VFR(7),o[3],0,0,0), C1,14); \
    }while(0)
  int t=1;
  #undef CMASK
  #define CMASK(P0,P1,t) do{}while(0)
  for(;t+5<NT;t+=2){
    STEP(pB0,pB1,pA0,pA1,t,true,true,true);     WAIT_BAR(3); RESC(); ROT();
    STEP(pA0,pA1,pB0,pB1,t+1,true,true,true);   WAIT_BAR(3); RESC(); ROT();
  }
  #undef CMASK
  #define CMASK(P0,P1,t) do{int jb_=(t)-(NT-4); if(jb_>=0)cmask(P0,P1,jb_,qrel,hi);}while(0)
  #define ENDW(tt) do{ if((tt)+3<NT){WAIT_BAR(3);} else if((tt)+2<NT){WAIT_BAR(2);} else {WAIT_BAR(0);} }while(0)
  for(;t+1<NT;t+=2){
    STEP(pB0,pB1,pA0,pA1,t,(t+3<NT),(t+1<NT),(t+1<NT));       ENDW(t);   RESC(); ROT();
    STEP(pA0,pA1,pB0,pB1,t+1,(t+4<NT),(t+2<NT),(t+2<NT));     ENDW(t+1); RESC(); ROT();
  }
  STEP(pB0,pB1,pA0,pA1,NT-1,false,false,false); RESC();
  { float sacc=pB0[0]+pB0[1]; _Pragma("unroll") for(int r=2;r<16;++r)sacc+=pB0[r]; _Pragma("unroll") for(int r=0;r<16;++r)sacc+=pB1[r]; l_reg+=sacc;
    pw0=(u32x4){PKW(pB0,0),PKW(pB0,2),PKW(pB0,4),PKW(pB0,6)};pw1=(u32x4){PKW(pB0,8),PKW(pB0,10),PKW(pB0,12),PKW(pB0,14)};pw2=(u32x4){PKW(pB1,0),PKW(pB1,2),PKW(pB1,4),PKW(pB1,6)};pw3=(u32x4){PKW(pB1,8),PKW(pB1,10),PKW(pB1,12),PKW(pB1,14)};
    SBAR(); pv(o,vb0+2*sl_cur,PAF(0),PAF(1),PAF(2),PAF(3)); }
  #undef PKW
  #undef PAF
  #undef VFR
  #undef PIN
  #undef MX3
  #undef GAPA
  #undef GAPB
  #undef EX
  #undef VRD
  #undef VRD2
  #undef KRD
  #undef STEP
  #undef ENDW
  asm volatile("s_waitcnt lgkmcnt(0)\n\ts_barrier":::"memory");
  #undef DMA_K
  #undef DMA_V
  #undef CMASK
  #undef START
  #undef RESC
  #undef ROT
}
constexpr int ZQA_=2048, ZKA_=2560, ZVA_=3072, MIXP=1024;
struct DiffParams { const bf16* Z; bf16* MIX; const float* g; float lam; float oscale; };
template<int THRL> __device__ __forceinline__ void diffattn_unit(int b,int h,int qb,const DiffParams&P,char*shm){
  const long rowbase=(long)b*SEQ; const int q0=qb*QB;
  #pragma unroll 1
  for(int c=0;c<2;++c){
    f32x16 o[4]; float l_reg;
    { const int wid0=__builtin_amdgcn_readfirstlane((int)threadIdx.x>>6);
      const bf16*Qw=P.Z+(rowbase+q0+wid0*QBLK)*DM+ZQA_+h*128+c*64;
      const bf16*Kh=P.Z+rowbase*DM+ZKA_+h*128+c*64; const bf16*Vh=P.Z+rowbase*DM+ZVA_+h*128;
      attn_pass<THRL>(Qw,Kh,Vh,q0,shm,o,l_reg); }
    int tid=threadIdx.x; asm volatile("":"+v"(tid));
    const int lane=tid&63,r32=lane&31,hi=lane>>5; const int wid=__builtin_amdgcn_readfirstlane(tid>>6);
    float*wsf=(float*)(shm+LDS_WS)+wid*64;
    unsigned*stA=(unsigned*)(shm+LDS_ST+wid*8192)+lane;
    {auto rr=__builtin_amdgcn_permlane32_swap(__float_as_uint(l_reg),__float_as_uint(l_reg),false,false);l_reg=__uint_as_float(rr[0])+__uint_as_float(rr[1]);}
    if(hi==0)wsf[32+r32]=l_reg;asm volatile("s_waitcnt lgkmcnt(0)":::"memory");
    #pragma unroll
    for(int r=0;r<16;++r){const float rl=__builtin_amdgcn_rcpf(wsf[32+crow(r,hi)]);o[0][r]*=rl;o[1][r]*=rl;o[2][r]*=rl;o[3][r]*=rl;}
    if(c==0){
      #pragma unroll
      for(int k=0;k<32;++k)stA[k*64]=cvtpk_s(o[k>>3][2*(k&7)],o[k>>3][2*(k&7)+1]);
    }else{
      #pragma unroll
      for(int k=0;k<32;++k){const unsigned a=stA[k*64];
        o[k>>3][2*(k&7)]=__uint_as_float(a<<16)-P.lam*o[k>>3][2*(k&7)];
        o[k>>3][2*(k&7)+1]=__uint_as_float(a&0xffff0000u)-P.lam*o[k>>3][2*(k&7)+1];}
      float ss[16];
      #pragma unroll
      for(int r=0;r<16;++r)ss[r]=(o[0][r]*o[0][r]+o[1][r]*o[1][r])+(o[2][r]*o[2][r]+o[3][r]*o[3][r]);
      { const bool b4=(lane&16)!=0,b3=(lane&8)!=0,b2=(lane&4)!=0,b1=(lane&2)!=0;
        float t8[8],t4[4],t2[2],t1;
        #pragma unroll
        for(int i=0;i<8;++i){const float keep=b4?ss[i+8]:ss[i],send=b4?ss[i]:ss[i+8];t8[i]=keep+__shfl_xor(send,16);}
        #pragma unroll
        for(int i=0;i<4;++i){const float keep=b3?t8[i+4]:t8[i],send=b3?t8[i]:t8[i+4];t4[i]=keep+__shfl_xor(send,8);}
        #pragma unroll
        for(int i=0;i<2;++i){const float keep=b2?t4[i+2]:t4[i],send=b2?t4[i]:t4[i+2];t2[i]=keep+__shfl_xor(send,4);}
        {const float keep=b1?t2[1]:t2[0],send=b1?t2[0]:t2[1];t1=keep+__shfl_xor(send,2);}
        t1+=__shfl_xor(t1,1);
        if((lane&1)==0)wsf[hi*16+((lane>>1)&15)]=__builtin_amdgcn_rsqf(t1*(1.0f/128.0f)+1e-5f)*P.oscale; }
      asm volatile("s_waitcnt lgkmcnt(0)":::"memory");
      const float g0=P.g[h*128+r32],g1=P.g[h*128+32+r32],g2=P.g[h*128+64+r32],g3=P.g[h*128+96+r32];
      bf16*st=(bf16*)(shm+LDS_ST+wid*8192);
      #pragma unroll
      for(int r=0;r<16;++r){const float rs=wsf[hi*16+r];const int orow=crow(r,hi);
        st[orow*128+r32]=__float2bfloat16(o[0][r]*rs*g0); st[orow*128+32+r32]=__float2bfloat16(o[1][r]*rs*g1);
        st[orow*128+64+r32]=__float2bfloat16(o[2][r]*rs*g2); st[orow*128+96+r32]=__float2bfloat16(o[3][r]*rs*g3);}
      asm volatile("s_waitcnt lgkmcnt(0)":::"memory");
      bf16*mo=P.MIX+(rowbase+q0+wid*QBLK)*MIXP+512+h*128;
      #pragma unroll
      for(int i=0;i<8;++i){const int row=i*4+(lane>>4),ch=lane&15;
        const u32x4 v=*(const u32x4*)(st+row*128+ch*8); *(u32x4*)(mo+(long)row*MIXP+ch*8)=v;}
    }
  }
}
template<int THRL=8> __device__ __forceinline__ void diffattn_queue(char*lds,const DiffParams&P,unsigned*qctr,volatile __attribute__((address_space(3))) unsigned*slot,const int j){
  for(;;){
    __syncthreads();
    if(threadIdx.x==0)*slot=__hip_atomic_fetch_add(qctr+64*j,1u,__ATOMIC_RELAXED,__HIP_MEMORY_SCOPE_AGENT);
    __syncthreads();
    const unsigned v=(unsigned)__builtin_amdgcn_readfirstlane((int)*slot);
    if(v>=64u)break;
#if ATTN_ORDER == 0
    const int bh=8*j+(int)(v>>3),qb=7-(int)(v&7u);
#elif ATTN_ORDER == 1
    const int bh=8*j+(int)(v&7u),qb=7-(int)(v>>3);
#elif ATTN_ORDER == 2
    const int bh=8*j+4*(int)(v>>5)+(int)(v&3u),qb=7-(int)((v&31u)>>2);
#else
    const int bh=8*j+2*(int)(v>>4)+(int)(v&1u),qb=7-(int)((v&15u)>>1);
#endif
    diffattn_unit<THRL>(bh>>2,bh&3,qb,P,lds);
  }
}
constexpr int ATTN_LDS_BYTES=LDS_BYTES;
#undef SBAR
#undef WAIT_BAR
}
namespace mls {
#define MLAS __attribute__((address_space(3)))
typedef short bf16x8 __attribute__((ext_vector_type(8)));
typedef float f32x4 __attribute__((ext_vector_type(4)));
typedef unsigned u32x4 __attribute__((ext_vector_type(4)));
typedef unsigned u32x2 __attribute__((ext_vector_type(2)));
constexpr int SEQ = 2048, ZP = 3584, ZQM = 0, ZKM = 512, ZVM = 1024, ZOM = 1536, MIXP = 1024;
constexpr int PQ = 136, PT = 72, PV = 152, PH = 132;
constexpr int O_QS = 0, O_KS = 17408, O_HS = 0, O_KW = 34816, O_VS = 52224, O_SC = 71680, O_CB = 80896, O_SCAL = 120064, O_CW = 121088, O_CH = 126208, O_GM = 126720, O_HB = 127232, O_DEN = 144640, O_SCAL2 = 144896, LDS_BYTES = 145920;
static_assert(O_KS == 64 * PQ * 2 && O_KW == 2 * 64 * PQ * 2 && O_VS == O_KW + 64 * PQ * 2 && O_SC == O_VS + 64 * PV * 2 && O_CB == O_SC + 64 * PT * 2 && O_SCAL == O_CB + 144 * PQ * 2 && O_CW == O_SCAL + 1024 && O_CH == O_CW + 5120 && O_GM == O_CH + 512 && O_HB == O_GM + 512 && O_DEN == O_HB + 64 * PQ * 2 && O_SCAL2 == O_DEN + 256 && LDS_BYTES == O_SCAL2 + 1024, "mLSTM LDS map");
struct Params { const unsigned short* Z; const unsigned short* QC  ; unsigned short* MIX; float* scal  ; const float* cht  ; const float* gates; const float* conv_w; const float* conv_b; const float* b_gates; const float* g_mh; };
typedef float f32x2_t __attribute__((ext_vector_type(2))); typedef __bf16 bf16x2_t __attribute__((ext_vector_type(2)));
__device__ __forceinline__ unsigned cvt2(float lo, float hi) { f32x2_t v = {lo, hi}; bf16x2_t b = __builtin_convertvector(v, bf16x2_t); return __builtin_bit_cast(unsigned, b); }
__device__ __forceinline__ void unpk8(const u32x4& w, float* f) {
    f[0] = __uint_as_float(w.x << 16); f[1] = __uint_as_float(w.x & 0xffff0000u); f[2] = __uint_as_float(w.y << 16); f[3] = __uint_as_float(w.y & 0xffff0000u);
    f[4] = __uint_as_float(w.z << 16); f[5] = __uint_as_float(w.z & 0xffff0000u); f[6] = __uint_as_float(w.w << 16); f[7] = __uint_as_float(w.w & 0xffff0000u);
}
__device__ __forceinline__ float scan_add(float v, int lane) {
#pragma unroll
    for (int d = 1; d < 64; d <<= 1) { const float t = __shfl_up(v, d); if (lane >= d) v += t; }
    return v;
}
__device__ __forceinline__ float scan_max(float v, int lane) {
#pragma unroll
    for (int d = 1; d < 64; d <<= 1) { const float t = __shfl_up(v, d); if (lane >= d) v = fmaxf(v, t); }
    return v;
}
__device__ __forceinline__ float wave_max(float v) {
#pragma unroll
    for (int o = 1; o < 64; o <<= 1) v = fmaxf(v, __shfl_xor(v, o));
    return v;
}
__device__ __forceinline__ float wave_add(float v) {
#pragma unroll
    for (int o = 1; o < 64; o <<= 1) v += __shfl_xor(v, o);
    return v;
}
#define MFMA16(a, b, c) __builtin_amdgcn_mfma_f32_16x16x32_bf16(a, b, c, 0, 0, 0)
#define LDFRAG(off) (*(const MLAS bf16x8*)(lds + (off)))
typedef short v4i16_t __attribute__((ext_vector_type(4)));
__device__ __forceinline__ bf16x8 trfrag(MLAS unsigned char* lds, int off, int pitch, int fr, int g) {
    MLAS unsigned char* p = lds + off + ((8 * g + (fr >> 2)) * pitch + 4 * (fr & 3)) * 2;
    const v4i16_t a = __builtin_amdgcn_ds_read_tr16_b64_v4i16((MLAS v4i16_t*)p), b = __builtin_amdgcn_ds_read_tr16_b64_v4i16((MLAS v4i16_t*)(p + 4 * pitch * 2));
    return (bf16x8){a[0], a[1], a[2], a[3], b[0], b[1], b[2], b[3]};
}

template <int VAR> __device__ __forceinline__ void unit(const Params& P, int b, int h, MLAS unsigned char* lds, const int c_begin, const int c_end) {
    int tid_ = threadIdx.x; asm volatile("" : "+v"(tid_));
    const int tid = tid_, lane0 = tid & 63, wave = __builtin_amdgcn_readfirstlane(tid >> 6);
#define MLS_LANE() int lane_ = lane0; asm volatile("" : "+v"(lane_)); const int lane = lane_, fr = lane & 15, g = lane >> 4; (void)fr; (void)g
    const size_t seq0 = (size_t)b * SEQ;
    for (int i = tid; i < 144 * PQ / 2; i += 512) ((MLAS unsigned*)(lds + O_CB))[i] = 0u;
    if (tid < 128) ((MLAS float*)(lds + O_GM))[tid] = P.g_mh[h * 128 + tid];
    for (int i = tid; i < 64 * 12; i += 512) { const int r = i / 12, c = i % 12; ((MLAS unsigned*)(lds + O_VS + (r * PV + 128) * 2))[c] = (c == 0) ? 0x00003f80u : 0u; }
    for (int i = tid; i < 2 * 5 * 128; i += 512) { const int qk = i / 640, tap = (i / 128) % 5, d = i & 127;
        ((MLAS float*)(lds + O_CW))[i] = (tap < 4) ? P.conv_w[tap * 1024 + qk * 512 + h * 128 + d] : P.conv_b[qk * 512 + h * 128 + d]; }
    f32x4 cacc[9];
#pragma unroll
    for (int eb = 0; eb < 9; ++eb) cacc[eb] = (f32x4){0.f, 0.f, 0.f, 0.f};
    const float kscale = 0.08838834764831845f;
    float* scalb = P.scal;
    { MLS_LANE(); MLAS float* chp = (MLAS float*)(lds + O_CH); const float bi = P.b_gates[h], bfg = P.b_gates[4 + h];
#pragma unroll 1
      for (int cc = 0; cc < 4; ++cc) { const int c = 4 * wave + cc; const size_t row = seq0 + 64 * c + lane;
          const float gi = P.gates[row * 8 + h] + bi, gf = P.gates[row * 8 + 4 + h] + bfg;
          const float lf = fminf(gf, 0.f) - log1pf(__expf(-fabsf(gf)));
          const float bc = scan_add(lf, lane); const float u = gi - bc; const float amax = scan_max(u, lane);
          *(f32x4*)(scalb + (size_t)(64 * c + lane) * 4) = (f32x4){u, bc, amax, 0.f};
          const float blast = __shfl(bc, 63), gmax = blast + __shfl(amax, 63);
          if (lane == 0) { chp[c] = blast; chp[32 + c] = gmax; } } }
    asm volatile("s_waitcnt vmcnt(0)" ::: "memory");
    __syncthreads();
    if (tid == 0) { MLAS float* chp = (MLAS float*)(lds + O_CH); float m = 0.f;
#pragma unroll 1
        for (int c = 0; c < 32; ++c) { chp[64 + c] = m; m = fmaxf(chp[c] + m, chp[32 + c]); }
        chp[96] = m; }
    u32x4 qrow[5], krow[5], vrow[2], ograw[2]; f32x4 sc_own; float u_r0, u_r1;
#define MLS_LOAD_RAW(ch) do { const int t0_ = (ch) * 64, p_ = 4 * wave + (lane >> 4), d8_ = lane & 15; \
        _Pragma("unroll") for (int j_ = 0; j_ < 5; ++j_) { int tt_ = t0_ + 2 * p_ - 3 + j_; tt_ = tt_ < 0 ? 0 : tt_; const unsigned short* zr_ = P.Z + (seq0 + tt_) * ZP + h * 128 + 8 * d8_; \
            qrow[j_] = *(const u32x4*)(zr_ + ZQM); krow[j_] = *(const u32x4*)(zr_ + ZKM); if (j_ >= 3) vrow[j_ - 3] = *(const u32x4*)(zr_ + ZVM); } \
        _Pragma("unroll") for (int it_ = 0; it_ < 2; ++it_) ograw[it_] = *(const u32x4*)(P.Z + (seq0 + t0_ + wave * 8 + 4 * it_ + (lane >> 4)) * ZP + ZOM + h * 128 + 8 * (lane & 15)); \
        sc_own = *(const f32x4*)(scalb + (size_t)(t0_ + lane) * 4); u_r0 = scalb[(size_t)(t0_ + 2 * p_) * 4]; u_r1 = scalb[(size_t)(t0_ + 2 * p_ + 1) * 4]; } while (0)
#define MLS_LOAD_KV(ch) do { const int t0_ = (ch) * 64, p_ = 4 * wave + (lane >> 4), d8_ = lane & 15; \
        _Pragma("unroll") for (int j_ = 0; j_ < 5; ++j_) { int tt_ = t0_ + 2 * p_ - 3 + j_; tt_ = tt_ < 0 ? 0 : tt_; const unsigned short* zr_ = P.Z + (seq0 + tt_) * ZP + h * 128 + 8 * d8_; \
            krow[j_] = *(const u32x4*)(zr_ + ZKM); if (j_ >= 3) vrow[j_ - 3] = *(const u32x4*)(zr_ + ZVM); } \
        u_r0 = scalb[(size_t)(t0_ + 2 * p_) * 4]; u_r1 = scalb[(size_t)(t0_ + 2 * p_ + 1) * 4]; } while (0)
    __syncthreads();
    { MLS_LANE(); if (c_begin > 0) { MLS_LOAD_KV(0); qrow[0] = qrow[1] = qrow[2] = qrow[3] = qrow[4] = ograw[0] = ograw[1] = krow[0]; sc_own = (f32x4){0.f, 0.f, 0.f, 0.f}; } else MLS_LOAD_RAW(0); }
    if (VAR & 1) { _Pragma("unroll") for (int j = 0; j < 5; ++j) { qrow[j] = (u32x4){0x3f803f80u, 0x3f803f80u, 0x3f803f80u, 0x3f803f80u}; krow[j] = qrow[j]; } vrow[0] = qrow[0]; vrow[1] = qrow[0]; }
#pragma unroll 1
    for (int ch = 0; ch < c_end; ++ch) {
        const int t0 = ch * 64; const bool full = ch >= c_begin;
        float decay, mstc;
        u32x4 og[2];
        { MLS_LANE();
        og[0] = ograw[0]; og[1] = ograw[1];
        const MLAS float* chp = (const MLAS float*)(lds + O_CH);
        mstc = chp[64 + ch]; const float mnew = chp[65 + ch], blast = chp[ch];
        decay = __expf(blast + mstc - mnew);
        const float ws0 = __expf(blast + u_r0 - mnew), ws1 = __expf(blast + u_r1 - mnew);
        if (full && wave == 0) { MLAS float* sc = (MLAS float*)(lds + ((ch & 1) ? O_SCAL2 : O_SCAL)); sc[lane] = sc_own[0]; sc[64 + lane] = sc_own[1]; sc[128 + lane] = fmaxf(mstc, sc_own[2]); }
        if (!(VAR & 4)) {
        const int p = 4 * wave + (lane >> 4), d8 = lane & 15;
        float k0[8], k1[8];
        { const MLAS f32x4* cw = (const MLAS f32x4*)(lds + O_CW) + 2 * d8;
#define MLS_CONV(QK, RAW, O0, O1) do { { const f32x4 ba_ = cw[((QK) * 5 + 4) * 32], bb_ = cw[((QK) * 5 + 4) * 32 + 1]; \
              _Pragma("unroll") for (int x_ = 0; x_ < 4; ++x_) { O0[x_] = ba_[x_]; O1[x_] = ba_[x_]; O0[4 + x_] = bb_[x_]; O1[4 + x_] = bb_[x_]; } } \
            f32x4 pa_ = (f32x4){0.f, 0.f, 0.f, 0.f}, pb_ = pa_; \
            _Pragma("unroll") for (int j_ = 0; j_ < 5; ++j_) { float f_[8]; unpk8(RAW[j_], f_); \
                if (ch == 0 && j_ < 3) { const bool ok_ = (2 * p - 3 + j_) >= 0; _Pragma("unroll") for (int x_ = 0; x_ < 8; ++x_) f_[x_] = ok_ ? f_[x_] : 0.f; } \
                f32x4 wa_ = pa_, wb_ = pb_; if (j_ < 4) { wa_ = cw[((QK) * 5 + j_) * 32]; wb_ = cw[((QK) * 5 + j_) * 32 + 1]; \
                    _Pragma("unroll") for (int x_ = 0; x_ < 4; ++x_) { O0[x_] += f_[x_] * wa_[x_]; O0[4 + x_] += f_[4 + x_] * wb_[x_]; } } \
                if (j_ >= 1) { _Pragma("unroll") for (int x_ = 0; x_ < 4; ++x_) { O1[x_] += f_[x_] * pa_[x_]; O1[4 + x_] += f_[4 + x_] * pb_[x_]; } } \
                pa_ = wa_; pb_ = wb_; } } while (0)
          MLS_CONV(1, krow, k0, k1);
#pragma unroll
          for (int j = 0; j < 8; ++j) { k0[j] = k0[j] * __builtin_amdgcn_rcpf(1.0f + __expf(-k0[j])) * kscale; k1[j] = k1[j] * __builtin_amdgcn_rcpf(1.0f + __expf(-k1[j])) * kscale; }
          if (full) {
          float q0[8], q1[8];
          MLS_CONV(0, qrow, q0, q1);
#pragma unroll
          for (int j = 0; j < 8; ++j) { q0[j] = q0[j] * __builtin_amdgcn_rcpf(1.0f + __expf(-q0[j])); q1[j] = q1[j] * __builtin_amdgcn_rcpf(1.0f + __expf(-q1[j])); }
          u32x4 wq; wq.x = cvt2(q0[0], q0[1]); wq.y = cvt2(q0[2], q0[3]); wq.z = cvt2(q0[4], q0[5]); wq.w = cvt2(q0[6], q0[7]);
          *(MLAS u32x4*)(lds + O_QS + ((2 * p) * PQ + 8 * d8) * 2) = wq;
          wq.x = cvt2(q1[0], q1[1]); wq.y = cvt2(q1[2], q1[3]); wq.z = cvt2(q1[4], q1[5]); wq.w = cvt2(q1[6], q1[7]);
          *(MLAS u32x4*)(lds + O_QS + ((2 * p + 1) * PQ + 8 * d8) * 2) = wq;
          wq.x = cvt2(k0[0], k0[1]); wq.y = cvt2(k0[2], k0[3]); wq.z = cvt2(k0[4], k0[5]); wq.w = cvt2(k0[6], k0[7]);
          *(MLAS u32x4*)(lds + O_KS + ((2 * p) * PQ + 8 * d8) * 2) = wq;
          wq.x = cvt2(k1[0], k1[1]); wq.y = cvt2(k1[2], k1[3]); wq.z = cvt2(k1[4], k1[5]); wq.w = cvt2(k1[6], k1[7]);
          *(MLAS u32x4*)(lds + O_KS + ((2 * p + 1) * PQ + 8 * d8) * 2) = wq;
          }
#undef MLS_CONV
#pragma unroll
          for (int j = 0; j < 8; j += 2) { const unsigned a_ = cvt2(k0[j], k0[j + 1]), b_ = cvt2(k1[j], k1[j + 1]); k0[j] = __uint_as_float(a_ << 16); k0[j + 1] = __uint_as_float(a_ & 0xffff0000u); k1[j] = __uint_as_float(b_ << 16); k1[j + 1] = __uint_as_float(b_ & 0xffff0000u); }
        }
        u32x4 w; w.x = cvt2(k0[0] * ws0, k0[1] * ws0); w.y = cvt2(k0[2] * ws0, k0[3] * ws0); w.z = cvt2(k0[4] * ws0, k0[5] * ws0); w.w = cvt2(k0[6] * ws0, k0[7] * ws0);
        *(MLAS u32x4*)(lds + O_KW + ((2 * p) * PQ + 8 * d8) * 2) = w;
        w.x = cvt2(k1[0] * ws1, k1[1] * ws1); w.y = cvt2(k1[2] * ws1, k1[3] * ws1); w.z = cvt2(k1[4] * ws1, k1[5] * ws1); w.w = cvt2(k1[6] * ws1, k1[7] * ws1);
        *(MLAS u32x4*)(lds + O_KW + ((2 * p + 1) * PQ + 8 * d8) * 2) = w;
        *(MLAS u32x4*)(lds + O_VS + ((2 * p) * PV + 8 * d8) * 2) = vrow[0];
        *(MLAS u32x4*)(lds + O_VS + ((2 * p + 1) * PV + 8 * d8) * 2) = vrow[1];
        }
        if (!(VAR & 1) && ch + 1 < c_end) { if (ch + 1 >= c_begin) MLS_LOAD_RAW(ch + 1); else MLS_LOAD_KV(ch + 1); }
        }
        __syncthreads();
        f32x4 nacc[4], dacc = (f32x4){0.f, 0.f, 0.f, 0.f};
        { MLS_LANE();
        if (!full) { nacc[0] = nacc[1] = nacc[2] = nacc[3] = dacc; } else
        if (!(VAR & 8)) {
        { const int tb = wave >> 1; const MLAS float* sc = (const MLAS float*)(lds + ((ch & 1) ? O_SCAL2 : O_SCAL));
#pragma unroll
          for (int q = 0; q < 2; ++q) { const int sb = 2 * (wave & 1) + q;
            MLAS unsigned short* scp = (MLAS unsigned short*)(lds + O_SC) + (16 * tb + 4 * g) * PT + 16 * sb + fr;
            if (sb <= tb) { f32x4 acc = (f32x4){0.f, 0.f, 0.f, 0.f};
#pragma unroll
                for (int ks = 0; ks < 4; ++ks) acc = MFMA16(LDFRAG(O_QS + ((16 * tb + fr) * PQ + 32 * ks + 8 * g) * 2), LDFRAG(O_KS + ((16 * sb + fr) * PQ + 32 * ks + 8 * g) * 2), acc);
                const int s = 16 * sb + fr; const float us = sc[s];
                const f32x4 mmt = *(const MLAS f32x4*)(sc + 128 + 16 * tb + 4 * g);
#pragma unroll
                for (int i = 0; i < 4; ++i) { const int t = 16 * tb + 4 * g + i; const float wgt = (s <= t) ? __expf(us - mmt[i]) : 0.f;
                    scp[i * PT] = (unsigned short)(cvt2(acc[i] * wgt, 0.f) & 0xffffu); }
            } else {
#pragma unroll
                for (int i = 0; i < 4; ++i) scp[i * PT] = 0; }
          } }
        { bf16x8 bfr[4];
#pragma unroll
          for (int ks = 0; ks < 4; ++ks) bfr[ks] = LDFRAG(O_CB + ((16 * wave + fr) * PQ + 32 * ks + 8 * g) * 2);
          const MLAS float* mmp = (const MLAS float*)(lds + ((ch & 1) ? O_SCAL2 : O_SCAL)) + 128;
#pragma unroll
          for (int tbk = 0; tbk < 4; ++tbk) { f32x4 acc = (f32x4){0.f, 0.f, 0.f, 0.f};
#pragma unroll
              for (int ks = 0; ks < 4; ++ks) acc = MFMA16(LDFRAG(O_QS + ((16 * tbk + fr) * PQ + 32 * ks + 8 * g) * 2), bfr[ks], acc);
              const f32x4 mv = *(const MLAS f32x4*)(mmp + 16 * tbk + 4 * g); const f32x4 wv = {__expf(mstc - mv[0]), __expf(mstc - mv[1]), __expf(mstc - mv[2]), __expf(mstc - mv[3])}; nacc[tbk] = acc * wv; }
          if (wave < 4) {
#pragma unroll
              for (int ks = 0; ks < 4; ++ks) dacc = MFMA16(LDFRAG(O_QS + ((16 * wave + fr) * PQ + 32 * ks + 8 * g) * 2), LDFRAG(O_CB + ((128 + fr) * PQ + 32 * ks + 8 * g) * 2), dacc);
              const f32x4 mv = *(const MLAS f32x4*)(mmp + 16 * wave + 4 * g); const f32x4 wv = {__expf(mstc - mv[0]), __expf(mstc - mv[1]), __expf(mstc - mv[2]), __expf(mstc - mv[3])}; dacc = dacc * wv; } }
        } else { nacc[0] = nacc[1] = nacc[2] = nacc[3] = dacc; }
        }
        if (full) __syncthreads();
        { MLS_LANE();
        if (!(VAR & 8)) {
        if (full) {
        bf16x8 vfr[2];
#pragma unroll
        for (int ks = 0; ks < 2; ++ks) vfr[ks] = trfrag(lds, O_VS + ((32 * ks) * PV + 16 * wave) * 2, PV, fr, g);
#pragma unroll
        for (int tbk = 0; tbk < 4; ++tbk) {
#pragma unroll
            for (int ks = 0; ks < 2; ++ks) if (32 * ks <= 16 * tbk + 15) nacc[tbk] = MFMA16(LDFRAG(O_SC + ((16 * tbk + fr) * PT + 32 * ks + 8 * g) * 2), vfr[ks], nacc[tbk]);
            MLAS unsigned short* hp = (MLAS unsigned short*)(lds + O_HB) + (16 * tbk + 4 * g) * PQ + 16 * wave + fr;
#pragma unroll
            for (int i = 0; i < 4; i += 2) { const unsigned pk = cvt2(nacc[tbk][i], nacc[tbk][i + 1]); hp[i * PQ] = (unsigned short)(pk & 0xffffu); hp[(i + 1) * PQ] = (unsigned short)(pk >> 16); } }
        if (wave < 4) {
#pragma unroll
            for (int ks = 0; ks < 2; ++ks) if (32 * ks <= 16 * wave + 15) dacc = MFMA16(LDFRAG(O_SC + ((16 * wave + fr) * PT + 32 * ks + 8 * g) * 2), trfrag(lds, O_VS + ((32 * ks) * PV + 128) * 2, PV, fr, g), dacc);
            if (fr == 0) *(MLAS f32x4*)(lds + O_DEN + (16 * wave + 4 * g) * 4) = dacc; }
        }
        { bf16x8 afr[2];
#pragma unroll
          for (int ks = 0; ks < 2; ++ks) afr[ks] = trfrag(lds, O_KW + ((32 * ks) * PQ + 16 * wave) * 2, PQ, fr, g);
#pragma unroll
          for (int eb = 0; eb < 9; ++eb) { f32x4 c = cacc[eb] * decay;
#pragma unroll
              for (int ks = 0; ks < 2; ++ks) c = MFMA16(afr[ks], trfrag(lds, O_VS + ((32 * ks) * PV + 16 * eb) * 2, PV, fr, g), c);
              cacc[eb] = c;
              u32x2 w; w.x = cvt2(c[0], c[1]); w.y = cvt2(c[2], c[3]);
              *(MLAS u32x2*)(lds + O_CB + ((16 * eb + fr) * PQ + 16 * wave + 4 * g) * 2) = w; } }
        }
        }
        __syncthreads();
        { MLS_LANE();
        if (full && !(VAR & 2)) { const MLAS float* scd = (const MLAS float*)(lds + ((ch & 1) ? O_SCAL2 : O_SCAL)); const MLAS float* bcp = scd + 64; const MLAS float* mmq = scd + 128;
#pragma unroll
          for (int it = 0; it < 2; ++it) { const int t = wave * 8 + 4 * it + (lane >> 4), c0 = 8 * (lane & 15);
              float nn[8]; { const u32x4 nw = *(const MLAS u32x4*)(lds + O_HB + (t * PQ + c0) * 2); unpk8(nw, nn); } const float den = ((const MLAS float*)(lds + O_DEN))[t];
              float ss = (nn[0] * nn[0] + nn[1] * nn[1]) + (nn[2] * nn[2] + nn[3] * nn[3]) + (nn[4] * nn[4] + nn[5] * nn[5]) + (nn[6] * nn[6] + nn[7] * nn[7]);
              ss += __shfl_xor(ss, 1); ss += __shfl_xor(ss, 2); ss += __shfl_xor(ss, 4); ss += __shfl_xor(ss, 8);
              const float dn = fmaxf(fabsf(den), __expf(-(bcp[t] + mmq[t])));
              const float rs = __builtin_amdgcn_rsqf(ss * (1.0f / 128.0f) + 1e-5f * dn * dn);
              float o[8]; unpk8(og[it], o); float gm[8]; { const f32x4 ga = *(const MLAS f32x4*)(lds + O_GM + c0 * 4), gb = *(const MLAS f32x4*)(lds + O_GM + c0 * 4 + 16); gm[0] = ga[0]; gm[1] = ga[1]; gm[2] = ga[2]; gm[3] = ga[3]; gm[4] = gb[0]; gm[5] = gb[1]; gm[6] = gb[2]; gm[7] = gb[3]; }
              float y[8];
#pragma unroll
              for (int j = 0; j < 8; ++j) y[j] = nn[j] * rs * gm[j] * o[j];
              u32x4 w; w.x = cvt2(y[0], y[1]); w.y = cvt2(y[2], y[3]); w.z = cvt2(y[4], y[5]); w.w = cvt2(y[6], y[7]);
              *(u32x4*)(P.MIX + (seq0 + t0 + t) * MIXP + h * 128 + c0) = w; } }
        }
    }
#undef MLS_LOAD_RAW
#undef MLS_LOAD_KV
}
#undef MFMA16
#undef LDFRAG
}

constexpr int NL = 4, BATCH = 16, SEQ = 2048, DM = 1024, M = BATCH * SEQ, FF = 2816, NIN = 3592;
constexpr int ZP = 3584;
constexpr int ZQM = 0, ZKM = 512, ZVM = 1024, ZOM = 1536, ZQA = 2048, ZKA = 2560, ZVA = 3072;
constexpr size_t HXB = (size_t)4096 * (3584 - 2816) * 2;
constexpr int NGU = 2 * FF;
constexpr float EPS = 1e-6f, HEAD_EPS = 1e-5f;
constexpr float C2 = 0.125f * 1.4426950408889634f;
constexpr int NWAVES = 8;
#ifndef MK_ONE_LAUNCH
#define MK_ONE_LAUNCH 1
#endif
constexpr bool USE_NAIVE_ATTN = false, USE_NAIVE_MLSTM = false;
constexpr bool SPLIT_MIXERS = false;
#ifndef ATTN_ORDER
#define ATTN_ORDER 1
#endif
#ifndef MLS_SEGS
#define MLS_SEGS 2
#endif
#ifndef MLS_SPLIT
#define MLS_SPLIT 16
#endif
#ifndef PROBE_MLS_VAR
#define PROBE_MLS_VAR 0
#endif
#ifndef PROBE_GU_VAR
#define PROBE_GU_VAR 1
#endif
#ifndef PROBE_DUP
#define PROBE_DUP 0
#endif
constexpr int N_PHASES = 2 + 6 * NL;

constexpr size_t MiB = 1u << 20;
constexpr size_t WS_CTL = 0, CTL_ZERO_BYTES = 1 * MiB;
constexpr size_t WIN_L = (size_t)ZP * DM * 2, WOUT_L = (size_t)DM * DM * 2, WGU_L = (size_t)NGU * DM * 2, WDN_L = (size_t)DM * FF * 2;
constexpr size_t WS_WIN = 2 * MiB, WS_WOUT = WS_WIN + NL * WIN_L, WS_WGU = WS_WOUT + NL * WOUT_L, WS_WDN = WS_WGU + NL * WGU_L;
constexpr size_t WS_WG = WS_WDN + NL * WDN_L;
constexpr size_t WS_COS = WS_WG + (size_t)NL * 8 * DM * 4, WS_SIN = WS_COS + (size_t)SEQ * 32 * 4;
constexpr size_t WS_ROWSS = 106 * MiB;
constexpr size_t WS_GATES = 108 * MiB;
constexpr size_t WS_SCAL = 109 * MiB;
constexpr size_t WS_CHT = 111 * MiB;
constexpr size_t WS_XB = 112 * MiB;
constexpr size_t WS_MIX = 176 * MiB;
constexpr size_t WS_Z = 240 * MiB;
constexpr size_t WS_SCALX = WS_Z + (size_t)M * ZP * 2;
constexpr size_t WS_END = WS_SCALX + (size_t)256 * SEQ * 16;
static_assert(WS_SIN + (size_t)SEQ * 32 * 4 <= WS_ROWSS && WS_END <= 512 * MiB, "d_ws map");
constexpr int CW_TMO = 0, CW_CODE = 1, CW_BAR = 4096, CW_QUEUE = 8192;

constexpr int RING_OFF = 0, RING_BYTES = 147456;
constexpr int LDSCTL_OFF = RING_BYTES, MISC_OFF = LDSCTL_OFF + 320;
constexpr int LDS_BYTES = 155648;

typedef float f32x4g __attribute__((ext_vector_type(4)));
__device__ __forceinline__ float bf2f(unsigned short b) { return __uint_as_float((unsigned)b << 16); }
__device__ __forceinline__ void unpack8(const v4u& w, float* f) {
    f[0] = __uint_as_float(w.x << 16); f[1] = __uint_as_float(w.x & 0xffff0000u); f[2] = __uint_as_float(w.y << 16); f[3] = __uint_as_float(w.y & 0xffff0000u);
    f[4] = __uint_as_float(w.z << 16); f[5] = __uint_as_float(w.z & 0xffff0000u); f[6] = __uint_as_float(w.w << 16); f[7] = __uint_as_float(w.w & 0xffff0000u);
}
__device__ __forceinline__ v4u pack8(const float* f) {
    v4u w; w.x = pg8::cvt_pk_bf16(f[0], f[1]); w.y = pg8::cvt_pk_bf16(f[2], f[3]); w.z = pg8::cvt_pk_bf16(f[4], f[5]); w.w = pg8::cvt_pk_bf16(f[6], f[7]); return w;
}

struct Args { const float* in[18]; float* out; unsigned char* ws; int ph_lo, ph_hi, mix_sel, pad; };
struct Frame {
    LAS unsigned char* lds;
    volatile LAS unsigned* MISC;
    int vcu, G, c;
    const Args* a;
};
#define PHASE_TID() int tid_ = threadIdx.x; asm volatile("" : "+v"(tid_)); const int tid = tid_, lane = tid & 63, wave = __builtin_amdgcn_readfirstlane(tid >> 6); (void)tid; (void)lane; (void)wave
#define FIN(k) (F.a->in[k])
#define FWS(T, off) ((T*)(F.a->ws + (off)))

__device__ __forceinline__ float wave_sum(float v) {
#pragma unroll
    for (int o = 1; o < 64; o <<= 1) v += __shfl_xor(v, o);
    return v;
}

struct WItem { const float* W; const float* gk; bf16* WT; int ldw, src, K, dst, k0; };
__device__ __forceinline__ void p0_load(const WItem& w, int lane, f32x4 (&v)[8]) {
#pragma unroll
    for (int i = 0; i < 8; ++i) { const int k = w.k0 + 8 * i + (lane >> 3); v[i] = __builtin_nontemporal_load((const GAS f32x4*)(w.W + (size_t)k * w.ldw + w.src + 4 * (lane & 7))); if (w.gk) v[i] = v[i] * w.gk[k]; }
}
__device__ __forceinline__ void p0_store(const WItem& w, LAS float* scr, int lane, const f32x4 (&v)[8]) {
#pragma unroll
    for (int i = 0; i < 8; ++i) { LAS float* s = scr + (8 * i + (lane >> 3)) * 33 + 4 * (lane & 7); s[0] = v[i][0]; s[1] = v[i][1]; s[2] = v[i][2]; s[3] = v[i][3]; }
    LDS_WAIT(); asm volatile("" ::: "memory");
    const int c = lane & 7;
#pragma unroll
    for (int j = 0; j < 4; ++j) { const int n = (lane >> 3) + 8 * j; const LAS float* s = scr + (8 * c) * 33 + n;
        v4u o; o.x = pg8::cvt_pk_bf16(s[0 * 33], s[1 * 33]); o.y = pg8::cvt_pk_bf16(s[2 * 33], s[3 * 33]); o.z = pg8::cvt_pk_bf16(s[4 * 33], s[5 * 33]); o.w = pg8::cvt_pk_bf16(s[6 * 33], s[7 * 33]);
        __builtin_nontemporal_store(o, (GAS v4u*)(w.WT + (size_t)(w.dst + n) * w.K + w.k0 + 8 * c)); }
    LDS_WAIT(); asm volatile("" ::: "memory");
}
__constant__ double ROPE_INV[32] = {1.0, 0.7498942093324559, 0.5623413251903491, 0.4216965034285822, 0.31622776601683794, 0.23713737056616552, 0.1778279410038923, 0.1333521432163324,
    0.1, 0.07498942093324558, 0.05623413251903491, 0.042169650342858224, 0.03162277660168379, 0.023713737056616554, 0.01778279410038923, 0.01333521432163324,
    0.01, 0.007498942093324558, 0.005623413251903491, 0.004216965034285823, 0.0031622776601683794, 0.0023713737056616554, 0.0017782794100389228, 0.001333521432163324,
    0.001, 0.0007498942093324559, 0.0005623413251903491, 0.00042169650342858224, 0.00031622776601683794, 0.00023713737056616554, 0.00017782794100389227, 0.0001333521432163324};
__device__ __forceinline__ void sincos_d(double a, double& s, double& c) {
    const double k = __builtin_rint(a * 0.6366197723675814);
    double r = __builtin_fma(-k, 1.5707963267948966, a); r = __builtin_fma(-k, 6.123233995736766e-17, r);
    const double r2 = r * r;
    double sp = -7.647163731819816e-13; sp = sp * r2 + 1.6059043836821613e-10; sp = sp * r2 - 2.505210838544172e-08; sp = sp * r2 + 2.7557319223985893e-06; sp = sp * r2 - 0.0001984126984126984; sp = sp * r2 + 0.008333333333333333; sp = sp * r2 - 0.16666666666666666;
    const double sn = r + r * r2 * sp;
    double cp = 4.779477332387385e-14; cp = cp * r2 - 1.1470745597729725e-11; cp = cp * r2 + 2.08767569878681e-09; cp = cp * r2 - 2.755731922398589e-07; cp = cp * r2 + 2.48015873015873e-05; cp = cp * r2 - 0.001388888888888889; cp = cp * r2 + 0.041666666666666664; cp = cp * r2 - 0.5;
    const double cs = 1.0 + r2 * cp;
    const int q = (int)((long long)k & 3);
    s = (q == 0) ? sn : (q == 1) ? cs : (q == 2) ? -sn : -cs;
    c = (q == 0) ? cs : (q == 1) ? -sn : (q == 2) ? -cs : sn;
}
__device__ __forceinline__ void p0_prologue(Frame& F) {
    PHASE_TID();
    LAS float* scr = (LAS float*)(F.lds + RING_OFF + wave * 16384);
    const int gw = F.vcu * NWAVES + wave, NGW = F.G * NWAVES;
    constexpr int I_IN = 16 * 112, I_OUT = 16 * 32, I_GU = 16 * 176, I_DN = 44 * 32, I_L = I_IN + I_OUT + I_GU + I_DN;
#define P0_DECODE(it_, w_) do { const int l_ = (it_) / I_L; int r_ = (it_) % I_L; \
        if (r_ < I_IN) { const int kb_ = r_ / 112, G_ = r_ % 112; int src_; \
            if (G_ < 64) src_ = 32 * G_; \
            else if (G_ < 96) { const int rr_ = (G_ - 64) & 15, tile_ = rr_ >> 3, bj_ = (rr_ >> 2) & 1, grp_ = rr_ & 3; src_ = (G_ < 80 ? 2056 : 2568) + (2 * tile_ + (grp_ >> 1)) * 128 + (grp_ & 1) * 64 + bj_ * 32; } \
            else src_ = 3080 + 32 * (G_ - 96); \
            w_.W = FIN(2) + (size_t)l_ * DM * NIN; w_.gk = FIN(1) + l_ * DM; w_.WT = FWS(bf16, WS_WIN) + (size_t)l_ * ZP * DM; w_.ldw = NIN; w_.src = src_; w_.K = DM; w_.dst = 32 * G_; w_.k0 = 64 * kb_; } \
        else if ((r_ -= I_IN) < I_OUT) { const int kb_ = r_ / 32, G_ = r_ % 32; \
            w_.W = FIN(12) + (size_t)l_ * DM * DM; w_.gk = nullptr; w_.WT = FWS(bf16, WS_WOUT) + (size_t)l_ * DM * DM; w_.ldw = DM; w_.src = 32 * G_; w_.K = DM; w_.dst = 32 * G_; w_.k0 = 64 * kb_; } \
        else if ((r_ -= I_OUT) < I_GU) { const int kb_ = r_ / 176, G_ = r_ % 176, tile_ = G_ >> 3, q_ = G_ & 7; \
            w_.W = (q_ < 4 ? FIN(14) : FIN(15)) + (size_t)l_ * DM * FF; w_.gk = FIN(13) + l_ * DM; w_.WT = FWS(bf16, WS_WGU) + (size_t)l_ * NGU * DM; w_.ldw = FF; w_.src = 128 * tile_ + 32 * (q_ & 3); w_.K = DM; w_.dst = 32 * G_; w_.k0 = 64 * kb_; } \
        else { r_ -= I_GU; const int kb_ = r_ / 32, G_ = r_ % 32; \
            w_.W = FIN(16) + (size_t)l_ * FF * DM; w_.gk = nullptr; w_.WT = FWS(bf16, WS_WDN) + (size_t)l_ * DM * FF; w_.ldw = DM; w_.src = 32 * G_; w_.K = FF; w_.dst = 32 * G_; w_.k0 = 64 * kb_; } } while (0)
    { WItem wa, wb; f32x4 va[8], vb[8]; int it = gw; const int NIT = NL * I_L;
      if (it < NIT) { P0_DECODE(it, wa); p0_load(wa, lane, va); }
#pragma unroll 1
      while (it < NIT) {
          const bool hb = it + NGW < NIT; if (hb) { P0_DECODE(it + NGW, wb); p0_load(wb, lane, vb); }
          p0_store(wa, scr, lane, va); it += NGW; if (it >= NIT) break;
          const bool ha = it + NGW < NIT; if (ha) { P0_DECODE(it + NGW, wa); p0_load(wa, lane, va); }
          p0_store(wb, scr, lane, vb); it += NGW; } }
#undef P0_DECODE
    const int gt = (F.vcu * NWAVES + wave) * 64 + lane, NGT = F.G * NWAVES * 64;
    for (int i = gt; i < NL * 16 * DM; i += NGT) { const int l = i / (16 * DM), j = (i / DM) & 15, k = i % DM; const float v = (j < 8) ? FIN(2)[((size_t)l * DM + k) * NIN + 2048 + j] * FIN(1)[l * DM + k] : 0.f; FWS(bf16, WS_WG)[i] = (bf16)(pg8::cvt_pk_bf16(v, 0.f) & 0xffffu); }
    for (int i = gt; i < SEQ * 32; i += NGT) { const int pos = i >> 5, fi = i & 31; double s, c; sincos_d((double)pos * ROPE_INV[fi], s, c); _Float16* tp = FWS(_Float16, WS_COS) + ((size_t)pos * 4 + (fi >> 3)) * 16 + (fi & 7); tp[0] = (_Float16)(float)c; tp[8] = (_Float16)(float)s; }
#pragma unroll 1
    for (int m0 = gw * 4; m0 < M; m0 += NGW * 4) {
        f32x4 v[4][4];
#pragma unroll
        for (int r = 0; r < 4; ++r) { const GAS f32x4* xr = (const GAS f32x4*)(FIN(0) + (size_t)(m0 + r) * DM) + lane;
#pragma unroll
            for (int j = 0; j < 4; ++j) v[r][j] = __builtin_nontemporal_load(xr + 64 * j); }
#pragma unroll
        for (int r = 0; r < 4; ++r) { float s = 0.f;
#pragma unroll
            for (int j = 0; j < 4; ++j) s += (v[r][j].x * v[r][j].x + v[r][j].y * v[r][j].y) + (v[r][j].z * v[r][j].z + v[r][j].w * v[r][j].w);
            s = wave_sum(s);
            GAS unsigned long long* o8 = (GAS unsigned long long*)(FWS(bf16, WS_XB) + (size_t)(m0 + r) * DM) + lane;
#pragma unroll
            for (int j = 0; j < 4; ++j) o8[64 * j] = (unsigned long long)pg8::cvt_pk_bf16(v[r][j].x, v[r][j].y) | ((unsigned long long)pg8::cvt_pk_bf16(v[r][j].z, v[r][j].w) << 32);
            if (lane < 16) FWS(float, WS_ROWSS)[(size_t)(m0 + r) * 16 + lane] = (lane == 0) ? s : 0.f; }
    }
}


__device__ __forceinline__ void gates_phase(Frame& F, int l) {
    PHASE_TID();
    typedef short bf16x8g __attribute__((ext_vector_type(8)));
    const int gw = F.vcu * NWAVES + wave, fr = lane & 15, g = lane >> 4;
    const int rows_per_wave = M / (F.G * NWAVES);
    for (int r0 = gw * rows_per_wave; r0 < (gw + 1) * rows_per_wave; r0 += 16) {
        const bf16* xa = FWS(bf16, WS_XB) + (size_t)(r0 + fr) * DM + 8 * g; const bf16* wb = FWS(bf16, WS_WG) + ((size_t)l * 16 + fr) * DM + 8 * g;
        f32x4 qs[4];
#pragma unroll
        for (int i = 0; i < 4; ++i) qs[i] = *(const GAS f32x4*)(FWS(float, WS_ROWSS) + (size_t)(r0 + 4 * g + i) * 16 + 4 * (fr & 3));
        f32x4 acc = {0.f, 0.f, 0.f, 0.f};
#pragma unroll 1
        for (int hk = 0; hk < 2; ++hk) {
            bf16x8g a[16];
#pragma unroll
            for (int ks = 0; ks < 16; ++ks) a[ks] = *(const GAS bf16x8g*)(xa + 32 * (16 * hk + ks));
#pragma unroll
            for (int ks = 0; ks < 16; ks += 4) asm volatile("" : "+v"(a[ks]), "+v"(a[ks + 1]), "+v"(a[ks + 2]), "+v"(a[ks + 3]));
#pragma unroll
            for (int ks = 0; ks < 16; ++ks) { const bf16x8g b = *(const GAS bf16x8g*)(wb + 32 * (16 * hk + ks)); acc = __builtin_amdgcn_mfma_f32_16x16x32_bf16(a[ks], b, acc, 0, 0, 0); }
        }
#pragma unroll
        for (int i = 0; i < 4; ++i) { const int row = r0 + 4 * g + i;
            const f32x4 q = qs[i]; float s = (q[0] + q[1]) + (q[2] + q[3]);
            s += __shfl_xor(s, 1); s += __shfl_xor(s, 2);
            const float rs = __builtin_amdgcn_rsqf(s * (1.0f / 1024.0f) + EPS);
            if (fr < 8) FWS(float, WS_GATES)[(size_t)row * 8 + fr] = acc[i] * rs; }
    }
}

__device__ __forceinline__ void conv_phase(Frame& F, int l) {
    PHASE_TID();
    const int chunk = tid & 127, grp = tid >> 7, col = 8 * chunk;
    const int rbase = (int)blockIdx.x * (M / F.G) + grp * 32;
    const float* cw = FIN(3) + (size_t)l * 4096 + col; const float* cb = FIN(4) + (size_t)l * 1024 + col;
    float wt[4][8], bs[8];
#pragma unroll
    for (int j = 0; j < 4; ++j) { const f32x4 a = *(const GAS f32x4*)(cw + j * 1024), b = *(const GAS f32x4*)(cw + j * 1024 + 4); wt[j][0] = a[0]; wt[j][1] = a[1]; wt[j][2] = a[2]; wt[j][3] = a[3]; wt[j][4] = b[0]; wt[j][5] = b[1]; wt[j][6] = b[2]; wt[j][7] = b[3]; }
    { const f32x4 a = *(const GAS f32x4*)cb, b = *(const GAS f32x4*)(cb + 4); bs[0] = a[0]; bs[1] = a[1]; bs[2] = a[2]; bs[3] = a[3]; bs[4] = b[0]; bs[5] = b[1]; bs[6] = b[2]; bs[7] = b[3]; }
    const float osc = (chunk >= 64) ? 0.08838834764831845f : 1.0f;
    const bf16* zc = FWS(bf16, WS_Z) + col; bf16* qc = (bf16*)(F.a->out) + col;
    float w0[8], w1[8], w2[8];
    if ((rbase & (SEQ - 1)) == 0) {
#pragma unroll
        for (int x = 0; x < 8; ++x) { w0[x] = 0.f; w1[x] = 0.f; w2[x] = 0.f; }
    } else { const v4u a = *(const GAS v4u*)(zc + (size_t)(rbase - 3) * ZP), b = *(const GAS v4u*)(zc + (size_t)(rbase - 2) * ZP), c = *(const GAS v4u*)(zc + (size_t)(rbase - 1) * ZP); unpack8(a, w0); unpack8(b, w1); unpack8(c, w2); }
#pragma unroll 8
    for (int rr = 0; rr < 32; ++rr) { const size_t row = (size_t)(rbase + rr);
        float cur[8], y[8]; { const v4u rw = *(const GAS v4u*)(zc + row * ZP); unpack8(rw, cur); }
#pragma unroll
        for (int x = 0; x < 8; ++x) { const float a = bs[x] + w0[x] * wt[0][x] + w1[x] * wt[1][x] + w2[x] * wt[2][x] + cur[x] * wt[3][x];
            y[x] = a * __builtin_amdgcn_rcpf(1.0f + __expf(-a)) * osc; w0[x] = w1[x]; w1[x] = w2[x]; w2[x] = cur[x]; }
        *(GAS v4u*)(qc + row * 1024) = pack8(y); }
    { const int gw = (int)blockIdx.x * NWAVES + wave; if (gw < 64 * 32) { const int unit = gw >> 5, c = gw & 31, hh = unit & 3; const size_t row = (size_t)(unit >> 2) * SEQ + 64 * c + lane;
        const float gi = FWS(float, WS_GATES)[row * 8 + hh] + FIN(5)[l * 8 + hh], gf = FWS(float, WS_GATES)[row * 8 + 4 + hh] + FIN(5)[l * 8 + 4 + hh];
        const float lf = fminf(gf, 0.f) - log1pf(__expf(-fabsf(gf)));
        const float bc = mls::scan_add(lf, lane); const float u = gi - bc; const float amax = mls::scan_max(u, lane);
        *(GAS f32x4*)(FWS(float, WS_SCAL) + ((size_t)unit * SEQ + 64 * c + lane) * 4) = (f32x4){u, bc, amax, 0.f};
        const float blast = __shfl(bc, 63), gmax = blast + __shfl(amax, 63);
        if (lane == 0) { FWS(float, WS_CHT)[(unit * 32 + c) * 2] = blast; FWS(float, WS_CHT)[(unit * 32 + c) * 2 + 1] = gmax; } } }
}

constexpr int RSTD_OFF = LDSCTL_OFF + 1024;
__device__ __forceinline__ pg8::RstdTab stage_rstd(Frame& F, const pg8::StaticOrder& S) {
    PHASE_TID();
    pg8::Unit u0; pg8::RstdTab rt; rt.tab = (const LAS float*)(F.lds + RSTD_OFF); rt.pm0 = 0;
    if (!S.next(0, u0)) return rt;
    rt.pm0 = u0.pm;
#pragma unroll 1
    for (int k = 0; k < 3; ++k) { const int pm = u0.pm + 8 * k; if (pm >= M / 256) break;
        const float* p = FWS(float, WS_ROWSS) + ((size_t)pm * 256 + (tid >> 1)) * 16 + 8 * (tid & 1);
        const f32x4 a = *(const GAS f32x4*)p, b = *(const GAS f32x4*)(p + 4);
        float s = ((a[0] + a[1]) + (a[2] + a[3])) + ((b[0] + b[1]) + (b[2] + b[3]));
        s += __shfl_xor(s, 1);
        if ((tid & 1) == 0) ((LAS float*)(F.lds + RSTD_OFF))[k * 256 + (tid >> 1)] = __builtin_amdgcn_rsqf(s * (1.0f / 1024.0f) + EPS); }
    __syncthreads();
    return rt;
}

__device__ __forceinline__ void frame_init(Frame& F, const Args& args, unsigned char* lds) {
    F.lds = (LAS unsigned char*)lds;
    F.MISC = (volatile LAS unsigned*)(F.lds + MISC_OFF);
    F.G = gridDim.x; { const int bx = blockIdx.x; F.vcu = (F.G % 8 == 0) ? (bx % 8) * (F.G / 8) + bx / 8 : bx; F.c = bx; }
    F.a = &args;
}

__device__ __forceinline__ float layer_lambda(Frame& F, int l, float lam_init) {
    float a = 0.f, b = 0.f;
    for (int i = 0; i < 64; ++i) { a += FIN(7)[l * 64 + i] * FIN(8)[l * 64 + i]; b += FIN(9)[l * 64 + i] * FIN(10)[l * 64 + i]; }
    return __expf(a) - __expf(b) + lam_init;
}
__device__ __forceinline__ void attn_naive_unit(Frame& F, int l, int b, int h, int qb, float lam, float lam_init) {
    PHASE_TID();
    const int vh = tid >> 8, c = (tid >> 7) & 1, r = tid & 127;
    const int qpos = qb * 128 + r; const size_t row = (size_t)b * SEQ + qpos;
    LAS float* Ks = (LAS float*)(F.lds + RING_OFF); LAS float* Vs = Ks + 4096; LAS float* XCH = Vs + 4096; LAS float* SSQ = XCH + 16384;
    float q[64];
#pragma unroll
    for (int i = 0; i < 8; ++i) { const v4u w = *(const GAS v4u*)(FWS(bf16, WS_Z) + row * ZP + ZQA + h * 128 + c * 64 + 8 * i); unpack8(w, q + 8 * i); }
    float o[64];
#pragma unroll
    for (int e = 0; e < 64; ++e) o[e] = 0.f;
    float mrun = -INFINITY, lsum = 0.f;
    const int nk = qb * 128 + 128;
    for (int j0 = 0; j0 < nk; j0 += 32) {
        __syncthreads();
        { const int cc = tid >> 8, key = (tid >> 3) & 31, d8 = (tid & 7) * 8; float f[8];
          const v4u w = *(const GAS v4u*)(FWS(bf16, WS_Z) + ((size_t)b * SEQ + j0 + key) * ZP + ZKA + h * 128 + cc * 64 + d8); unpack8(w, f);
#pragma unroll
          for (int i = 0; i < 8; ++i) Ks[cc * 2048 + key * 64 + d8 + i] = f[i]; }
        { const int key = tid >> 4, e8 = (tid & 15) * 8; float f[8];
          const v4u w = *(const GAS v4u*)(FWS(bf16, WS_Z) + ((size_t)b * SEQ + j0 + key) * ZP + ZVA + h * 128 + e8); unpack8(w, f);
#pragma unroll
          for (int i = 0; i < 8; ++i) Vs[key * 128 + e8 + i] = f[i]; }
        __syncthreads();
#pragma unroll 1
        for (int key = 0; key < 32; ++key) {
            const LAS f32x4* kp = (const LAS f32x4*)(Ks + c * 2048 + key * 64); float d0 = 0.f, d1 = 0.f;
#pragma unroll
            for (int d = 0; d < 16; d += 2) { const f32x4 k0 = kp[d], k1 = kp[d + 1];
                d0 += q[4 * d] * k0.x + q[4 * d + 1] * k0.y + q[4 * d + 2] * k0.z + q[4 * d + 3] * k0.w;
                d1 += q[4 * d + 4] * k1.x + q[4 * d + 5] * k1.y + q[4 * d + 6] * k1.z + q[4 * d + 7] * k1.w; }
            const float sv = (j0 + key <= qpos) ? (d0 + d1) : -INFINITY;
            if (sv > mrun) { const float alpha = exp2f(mrun - sv); lsum *= alpha;
#pragma unroll
                for (int e = 0; e < 64; ++e) o[e] *= alpha;
                mrun = sv; }
            const float p = exp2f(sv - mrun); lsum += p; const LAS f32x4* vp = (const LAS f32x4*)(Vs + key * 128 + vh * 64);
#pragma unroll
            for (int e = 0; e < 16; ++e) { const f32x4 v = vp[e]; o[4 * e] += p * v.x; o[4 * e + 1] += p * v.y; o[4 * e + 2] += p * v.z; o[4 * e + 3] += p * v.w; }
        }
    }
    const float inv = 1.0f / lsum;
#pragma unroll
    for (int e = 0; e < 64; ++e) o[e] *= inv;
    __syncthreads();
    if (c == 1) {
#pragma unroll
        for (int e = 0; e < 64; ++e) XCH[(vh * 128 + r) * 64 + e] = o[e]; }
    __syncthreads();
    float ss = 0.f;
    if (c == 0) {
#pragma unroll
        for (int e = 0; e < 64; ++e) { o[e] = o[e] - lam * XCH[(vh * 128 + r) * 64 + e]; ss += o[e] * o[e]; }
        SSQ[vh * 128 + r] = ss; }
    __syncthreads();
    if (c == 0) {
        const float rs = rsqrtf((SSQ[r] + SSQ[128 + r]) * (1.0f / 128.0f) + HEAD_EPS) * (1.0f - lam_init);
        const float* g = FIN(11) + l * 512 + h * 128 + vh * 64;
#pragma unroll
        for (int i = 0; i < 8; ++i) { float f[8];
#pragma unroll
            for (int j = 0; j < 8; ++j) f[j] = o[8 * i + j] * rs * g[8 * i + j];
            *(GAS v4u*)(FWS(bf16, WS_MIX) + row * DM + 512 + h * 128 + vh * 64 + 8 * i) = pack8(f); }
    }
    __syncthreads();
}

constexpr int MLP = 132;
__device__ __forceinline__ void mlstm_naive_unit(Frame& F, int l, int b, int h) {
    PHASE_TID();
    LAS float* Qs = (LAS float*)(F.lds + RING_OFF); LAS float* Ks = Qs + 64 * MLP; LAS float* Vs = Ks + 64 * MLP; LAS float* Ss = Vs + 64 * MLP;
    LAS float* sc_ii = Ss + 64 * 65; LAS float* sc_bc = sc_ii + 64; LAS float* sc_mt = sc_bc + 64; LAS float* sc_wi = sc_mt + 64; LAS float* sc_ws = sc_wi + 64; LAS float* sc_rd = sc_ws + 64;
    LAS float* nvec = sc_rd + 64; LAS float* sc_misc = nvec + 128;
    LAS float* HI = sc_misc + 16;
    LAS float* Hs = Qs;
    const int e = tid >> 2, dq = tid & 3;
    float C[32];
#pragma unroll
    for (int i = 0; i < 32; ++i) C[i] = 0.f;
    if (tid < 128) nvec[tid] = 0.f;
    if (tid == 0) { sc_misc[0] = 0.f; sc_misc[1] = 0.f; }
    const float bi = FIN(5)[l * 8 + h], bfg = FIN(5)[l * 8 + 4 + h];
    const float* cw = FIN(3) + (size_t)l * 4 * 1024; const float* cb = FIN(4) + (size_t)l * 1024;
    const float kscale = 0.08838834764831845f;
    __syncthreads();
    for (int ch = 0; ch < 32; ++ch) {
        const int t0 = ch * 64; const size_t rowb = (size_t)b * SEQ + t0;
#pragma unroll 1
        for (int idx = tid; idx < 64 * 128; idx += 512) { const int t = idx >> 7, d = idx & 127;
            float aq = cb[h * 128 + d], ak = cb[512 + h * 128 + d];
#pragma unroll
            for (int j = 0; j < 4; ++j) { const int tt = t0 + t - 3 + j; if (tt >= 0) { const bf16* zr = FWS(bf16, WS_Z) + ((size_t)b * SEQ + tt) * ZP;
                aq += bf2f(zr[ZQM + h * 128 + d]) * cw[j * 1024 + h * 128 + d]; ak += bf2f(zr[ZKM + h * 128 + d]) * cw[j * 1024 + 512 + h * 128 + d]; } }
            Qs[t * MLP + d] = aq / (1.0f + __expf(-aq)); Ks[t * MLP + d] = ak / (1.0f + __expf(-ak)) * kscale;
            Vs[t * MLP + d] = bf2f(FWS(bf16, WS_Z)[(rowb + t) * ZP + ZVM + h * 128 + d]); }
        if (tid < 64) { const float ip = FWS(float, WS_GATES)[(rowb + tid) * 8 + h] + bi, fp = FWS(float, WS_GATES)[(rowb + tid) * 8 + 4 + h] + bfg;
            sc_ii[tid] = ip; sc_bc[tid] = fminf(fp, 0.f) - log1pf(__expf(-fabsf(fp))); }
        __syncthreads();
        if (tid == 0) { const float mst = sc_misc[0]; float cum = 0.f, amax = -INFINITY;
#pragma unroll 1
            for (int t = 0; t < 64; ++t) { cum += sc_bc[t]; sc_bc[t] = cum; amax = fmaxf(amax, sc_ii[t] - cum); const float inter = cum + mst; const float mt = fmaxf(inter, cum + amax);
                sc_mt[t] = mt; sc_wi[t] = __expf(inter - mt); }
            const float blast = cum; float gmax = -INFINITY;
#pragma unroll 1
            for (int s = 0; s < 64; ++s) gmax = fmaxf(gmax, blast - sc_bc[s] + sc_ii[s]);
            const float mnew = fmaxf(blast + mst, gmax);
#pragma unroll 1
            for (int s = 0; s < 64; ++s) sc_ws[s] = __expf(blast - sc_bc[s] + sc_ii[s] - mnew);
            sc_misc[1] = __expf(blast + mst - mnew); sc_misc[2] = mnew; }
        __syncthreads();
#pragma unroll 1
        for (int idx = tid; idx < 64 * 64; idx += 512) { const int t = idx >> 6, s = idx & 63; float v = 0.f;
            if (s <= t) { const LAS f32x4* qp = (const LAS f32x4*)(Qs + t * MLP); const LAS f32x4* kp = (const LAS f32x4*)(Ks + s * MLP); float d0 = 0.f;
#pragma unroll 8
                for (int d = 0; d < 32; ++d) { const f32x4 a = qp[d], k = kp[d]; d0 += a.x * k.x + a.y * k.y + a.z * k.z + a.w * k.w; }
                v = d0 * __expf(sc_bc[t] - sc_bc[s] + sc_ii[s] - sc_mt[t]); }
            Ss[t * 65 + s] = v; }
        __syncthreads();
        if (tid < 64) { const int t = tid; float den = 0.f;
#pragma unroll 4
            for (int s = 0; s < 64; ++s) den += Ss[t * 65 + s];
            float qn = 0.f;
#pragma unroll 4
            for (int d = 0; d < 128; ++d) qn += Qs[t * MLP + d] * nvec[d];
            den += sc_wi[t] * qn; sc_rd[t] = 1.0f / fmaxf(fabsf(den), __expf(-sc_mt[t])); }
#pragma unroll 1
        for (int t = 0; t < 64; ++t) { const LAS f32x4* qp = (const LAS f32x4*)(Qs + t * MLP + 32 * dq); float p = 0.f;
#pragma unroll
            for (int i = 0; i < 8; ++i) { const f32x4 a = qp[i]; p += a.x * C[4 * i] + a.y * C[4 * i + 1] + a.z * C[4 * i + 2] + a.w * C[4 * i + 3]; }
            p += __shfl_xor(p, 1); p += __shfl_xor(p, 2);
            if ((t & 3) == dq) HI[t * MLP + e] = p; }
        __syncthreads();
#pragma unroll 1
        for (int j = 0; j < 16; ++j) { const int t = 4 * j + dq; float a = 0.f;
#pragma unroll 4
            for (int s2 = 0; s2 < 64; ++s2) a += Ss[t * 65 + s2] * Vs[s2 * MLP + e];
            Hs[t * MLP + e] = (a + sc_wi[t] * HI[t * MLP + e]) * sc_rd[t]; }
        __syncthreads();
#pragma unroll 1
        for (int rr = 0; rr < 8; ++rr) { const int t = wave * 8 + rr; const float h0 = Hs[t * MLP + lane], h1 = Hs[t * MLP + 64 + lane];
            const float ss = wave_sum(h0 * h0 + h1 * h1); const float rs = rsqrtf(ss * (1.0f / 128.0f) + HEAD_EPS);
            const bf16* zr = FWS(bf16, WS_Z) + (rowb + t) * ZP + ZOM + h * 128; const float o0 = bf2f(zr[lane]), o1 = bf2f(zr[64 + lane]);
            const float y0 = h0 * rs * FIN(6)[l * 512 + h * 128 + lane] / (1.0f + __expf(-o0)), y1 = h1 * rs * FIN(6)[l * 512 + h * 128 + 64 + lane] / (1.0f + __expf(-o1));
            bf16* mo = FWS(bf16, WS_MIX) + (rowb + t) * DM + h * 128; mo[lane] = (bf16)(pg8::cvt_pk_bf16(y0, 0.f) & 0xffffu); mo[64 + lane] = (bf16)(pg8::cvt_pk_bf16(y1, 0.f) & 0xffffu); }
        { const float decay = sc_misc[1];
#pragma unroll
          for (int i = 0; i < 32; ++i) C[i] *= decay;
#pragma unroll 2
          for (int s = 0; s < 64; ++s) { const float ve = sc_ws[s] * Vs[s * MLP + e]; const LAS f32x4* kp = (const LAS f32x4*)(Ks + s * MLP + 32 * dq);
#pragma unroll
              for (int i = 0; i < 8; ++i) { const f32x4 k = kp[i]; C[4 * i] += ve * k.x; C[4 * i + 1] += ve * k.y; C[4 * i + 2] += ve * k.z; C[4 * i + 3] += ve * k.w; } }
          if (tid < 128) { float nn = decay * nvec[tid];
#pragma unroll 4
              for (int s = 0; s < 64; ++s) nn += sc_ws[s] * Ks[s * MLP + tid]; nvec[tid] = nn; }
          if (tid == 0) sc_misc[0] = sc_misc[2]; }
        __syncthreads();
    }
}


__global__ void __launch_bounds__(512) k_mlstm_naive(Args args, int l) {
    extern __shared__ __attribute__((aligned(16))) unsigned char lds[];
    Frame F; frame_init(F, args, lds);
    mlstm_naive_unit(F, l, (int)blockIdx.x >> 2, (int)blockIdx.x & 3);
}
__global__ void __launch_bounds__(512) k_attn_naive(Args args, int l) {
    extern __shared__ __attribute__((aligned(16))) unsigned char lds[];
    Frame F; frame_init(F, args, lds);
    const float lam_init = (l == 0) ? 0.20000000000000007f : (l == 1) ? 0.35550906759096934f : (l == 2) ? 0.4707130183435842f : 0.5560582041556406f;
    const float lam = layer_lambda(F, l, lam_init);
    const int u = (int)blockIdx.x; const int qb = 15 - (u >> 6), bh = u & 63;
    attn_naive_unit(F, l, bh >> 2, bh & 3, qb, lam, lam_init);
}

__device__ __forceinline__ void final_norm(Frame& F) {
    PHASE_TID();
    const int gw = F.vcu * NWAVES + wave, NGW = F.G * NWAVES;
    f32x4 g[4];
#pragma unroll
    for (int j = 0; j < 4; ++j) g[j] = ((const GAS f32x4*)FIN(17))[2 * lane + (j & 1) + 128 * (j >> 1)];
    for (int m = gw; m < M; m += NGW) {
        const bf16* xr = FWS(bf16, WS_XB) + (size_t)m * DM;
        float v[16]; { const v4u a = __builtin_nontemporal_load((const GAS v4u*)(xr + 8 * lane)), b = __builtin_nontemporal_load((const GAS v4u*)(xr + 512 + 8 * lane)); unpack8(a, v); unpack8(b, v + 8); }
        float s = 0.f;
#pragma unroll
        for (int j = 0; j < 16; ++j) s += v[j] * v[j];
        const float rs = rsqrtf(wave_sum(s) * (1.0f / DM) + EPS);
        GAS f32x4* o = (GAS f32x4*)((F.a->out) + (size_t)m * DM);
#pragma unroll
        for (int j = 0; j < 4; ++j) { const f32x4 x = {v[4 * j], v[4 * j + 1], v[4 * j + 2], v[4 * j + 3]}; __builtin_nontemporal_store(x * rs * g[j], &o[2 * lane + (j & 1) + 128 * (j >> 1)]); }
    }
}

__global__ void __launch_bounds__(NWAVES * 64, 2) trunk_fwd(Args args) {
    extern __shared__ __attribute__((aligned(16))) unsigned char lds[];
    Frame F; frame_init(F, args, lds);
    for (int u = threadIdx.x; u < (LDS_BYTES - LDSCTL_OFF) / 4; u += NWAVES * 64) ((LAS unsigned*)(F.lds + LDSCTL_OFF))[u] = 0u;
    __syncthreads();
#if MK_ONE_LAUNCH
    XcdBarrier bar; bar.bar = (unsigned*)(FWS(gu32, WS_CTL) + CW_BAR); bar.x = xb_xcc_id(); bar.st = F.MISC + 8;
    if (threadIdx.x == 0) F.MISC[20] = xb_add(&bar.bar[XB_XCNT(bar.x)], 1u);
    bool light = false;
#define GRID_BAR() xcd_barrier<false>(bar)
#define GRID_BAR_L() do { if (light) xcd_local_barrier(bar); else xcd_barrier<false>(bar); } while (0)
#else
#define GRID_BAR() do {} while (0)
#define GRID_BAR_L() do {} while (0)
#endif
    const int lo = args.ph_lo, hi = args.ph_hi;
#define IN(k) (lo <= (k) && (k) < hi)
#define BOTH(k) (IN(k) && IN((k) + 1))

    if (IN(0)) { p0_prologue(F); VM_WAIT(); __syncthreads(); if (BOTH(0)) GRID_BAR(); }
#if MK_ONE_LAUNCH
    { if (threadIdx.x == 0) { unsigned ok = (gridDim.x == 256u) ? 1u : 0u, n = 0u;
#pragma unroll 1
          for (unsigned j = 0; j < 16; ++j) { const unsigned cj = xb_ld(&bar.bar[XB_XCNT(j)]); if (cj) { ++n; if (cj != 32u || j >= 8u) ok = 0u; } }
          if (n != 8u || F.MISC[20] >= 32u) ok = 0u; F.MISC[21] = ok; }
      __syncthreads();
      light = __builtin_amdgcn_readfirstlane((int)F.MISC[21]) != 0;
      if (light) { const int cc = (int)bar.x + 8 * __builtin_amdgcn_readfirstlane((int)F.MISC[20]); F.c = cc; F.vcu = (cc % 8) * (F.G / 8) + cc / 8; } }
#endif
    if ((PROBE_DUP & 1) && IN(0)) { p0_prologue(F); VM_WAIT(); __syncthreads(); if (BOTH(0)) GRID_BAR(); }

    for (int l = 0; l < NL; ++l) {
        const int pb = 1 + 6 * l;
        const float lam_init = __uint_as_float((unsigned)__builtin_amdgcn_readfirstlane((int)__float_as_uint((l == 0) ? 0.20000000000000007f : (l == 1) ? 0.35550906759096934f : (l == 2) ? 0.4707130183435842f : 0.5560582041556406f)));
        for (int rep = 0; rep < ((PROBE_DUP & 2) ? 2 : 1); ++rep)
        if (IN(pb)) {
            gates_phase(F, l);
            pg8::Gemm g{FWS(bf16, WS_XB), FWS(bf16, WS_WIN) + (size_t)l * ZP * DM, M, ZP, DM, 0}; pg8::StaticOrder S; S.init(M, ZP, F.G, F.c);
            pg8::EpiIn E{FWS(bf16, WS_Z), ZP, stage_rstd(F, S), FWS(const _Float16, WS_COS), C2};
            pg8::gemm_phase<pg8::EpiIn, pg8::StaticOrder, true, true>(F.lds + RING_OFF, g, S, E);
            if (BOTH(pb)) GRID_BAR_L();
        }
#define MIXER_PHASE(rep) do { \
            const float lam = __uint_as_float((unsigned)__builtin_amdgcn_readfirstlane((int)__float_as_uint(layer_lambda(F, l, lam_init)))); \
            const attn_body::DiffParams P{(const attn_body::bf16*)FWS(bf16, WS_Z), (attn_body::bf16*)FWS(bf16, WS_MIX), FIN(11) + l * 512, lam, 1.0f - lam_init}; \
            if (!USE_NAIVE_MLSTM && (F.c >> 3) < 8 * MLS_SEGS && F.a->mix_sel != 2 && !((rep) == 1 && (PROBE_DUP & 32))) { \
                const int mseg = F.c >> 6, mbh = 8 * (F.c & 7) + ((F.c >> 3) & 7),     \
                 mcb = (mseg == 0) ? 0 : MLS_SPLIT, mce = (MLS_SEGS == 1 || mseg == 1) ? 32 : MLS_SPLIT; \
                const mls::Params MP{(const unsigned short*)FWS(bf16, WS_Z), (const unsigned short*)(F.a->out), (unsigned short*)FWS(bf16, WS_MIX), FWS(float, WS_SCALX) + (size_t)blockIdx.x * SEQ * 4, FWS(float, WS_CHT), FWS(float, WS_GATES), FIN(3) + (size_t)l * 4096, FIN(4) + (size_t)l * 1024, FIN(5) + l * 8, FIN(6) + l * 512}; \
                if (PROBE_MLS_VAR != 0 && (rep) == 1) { mls::Params MP2 = MP; MP2.MIX = (unsigned short*)(F.a->out) + (size_t)M * 1024; mls::unit<PROBE_MLS_VAR>(MP2, mbh >> 2, mbh & 3, F.lds + RING_OFF, mcb, mce); } else \
                mls::unit<0>(MP, mbh >> 2, mbh & 3, F.lds + RING_OFF, mcb, mce); \
            } \
            if (F.a->mix_sel != 1 && !((rep) == 1 && (PROBE_DUP & 16))) attn_body::diffattn_queue<8>((char*)lds + RING_OFF, P, (unsigned*)(FWS(gu32, WS_CTL) + CW_QUEUE + ((rep) * NL + l) * 8 * 64), F.MISC + 16, F.c & 7); \
            if (BOTH(pb + 2)) GRID_BAR_L(); \
        } while (0)
        if (IN(pb + 2)) { MIXER_PHASE(0); if (PROBE_DUP & (4 | 16 | 32)) MIXER_PHASE(1); }
#undef MIXER_PHASE
        if (IN(pb + 3)) {
            pg8::Gemm g{FWS(bf16, WS_MIX), FWS(bf16, WS_WOUT) + (size_t)l * DM * DM, M, DM, DM, 0}; pg8::StaticOrder S; S.init(M, DM, F.G, F.c);
            pg8::EpiRes E{FWS(bf16, WS_XB), FWS(float, WS_ROWSS)};
            pg8::gemm_phase<pg8::EpiRes, pg8::StaticOrder, true, true>(F.lds + RING_OFF, g, S, E);
            if (BOTH(pb + 3)) GRID_BAR_L();
        }
        for (int rep = 0; rep < ((PROBE_DUP & 8) ? 2 : 1); ++rep)
        if (IN(pb + 4)) {
            pg8::Gemm g{FWS(bf16, WS_XB), FWS(bf16, WS_WGU) + (size_t)l * NGU * DM, M, NGU, DM, 0}; pg8::StaticOrder S; S.init(M, NGU, F.G, F.c);
#if (PROBE_DUP & 256)
            { pg8::EpiGU<PROBE_GU_VAR> E2{FWS(bf16, WS_Z), FF, stage_rstd(F, S), HXB / 2}; pg8::gemm_phase<pg8::EpiGU<PROBE_GU_VAR>, pg8::StaticOrder, true, true>(F.lds + RING_OFF, g, S, E2); GRID_BAR(); }
#endif
            pg8::EpiGU<0> E{FWS(bf16, WS_Z), FF, stage_rstd(F, S), HXB / 2};
            pg8::gemm_phase<pg8::EpiGU<0>, pg8::StaticOrder, true, true>(F.lds + RING_OFF, g, S, E);
            if (BOTH(pb + 4)) GRID_BAR_L();
        }
        if (IN(pb + 5)) {
            pg8::Gemm g{FWS(bf16, WS_Z), FWS(bf16, WS_WDN) + (size_t)l * DM * FF, M, DM, FF, HXB}; pg8::ReverseOrder S; S.init(M, DM, F.G, F.c);
            pg8::EpiRes E{FWS(bf16, WS_XB), FWS(float, WS_ROWSS)};
            pg8::gemm_phase<pg8::EpiRes, pg8::ReverseOrder, true, true>(F.lds + RING_OFF, g, S, E);
            if (BOTH(pb + 5)) { if (l == NL - 1) GRID_BAR(); else GRID_BAR_L(); }
        }
    }
    if (IN(N_PHASES - 1)) final_norm(F);
#undef IN
#undef BOTH
}

extern "C" void kernel_launch(void* const* d_in, const int* in_sizes, int n_in, void* d_out, int out_size, void* d_ws, size_t ws_size, hipStream_t stream) {
    static int grid = 0;
    if (grid == 0) {
        if (n_in != 18 || out_size != M * DM || ws_size < WS_END) { fprintf(stderr, "kernel_launch: unexpected shapes (n_in %d, out %d, ws %zu, need %zu)\n", n_in, out_size, ws_size, (size_t)WS_END); grid = -1; return; }
        int dev = 0, cus = 0;
        if (hipGetDevice(&dev) != hipSuccess || hipDeviceGetAttribute(&cus, hipDeviceAttributeMultiprocessorCount, dev) != hipSuccess) { grid = -1; return; }
        if (hipFuncSetAttribute((const void*)trunk_fwd, hipFuncAttributeMaxDynamicSharedMemorySize, LDS_BYTES) != hipSuccess) { grid = -1; return; }
        if (hipFuncSetAttribute((const void*)k_mlstm_naive, hipFuncAttributeMaxDynamicSharedMemorySize, 160000) != hipSuccess || hipFuncSetAttribute((const void*)k_attn_naive, hipFuncAttributeMaxDynamicSharedMemorySize, 131072) != hipSuccess) { grid = -1; return; }
        int per_cu = 0;
        if (hipOccupancyMaxActiveBlocksPerMultiprocessor(&per_cu, (const void*)trunk_fwd, NWAVES * 64, LDS_BYTES) != hipSuccess || per_cu < 1) { fprintf(stderr, "kernel_launch: occupancy query says %d workgroups per CU; nothing launched\n", per_cu); grid = -1; return; }
        (void)hipGetLastError();
        if (cus < 256) { fprintf(stderr, "kernel_launch: built for a 256-CU device, found %d CUs; nothing launched\n", cus); grid = -1; return; }
        grid = 256;
    }
    if (grid < 0) return;
    (void)in_sizes;
    if (hipMemsetAsync((char*)d_ws + WS_CTL, 0, CTL_ZERO_BYTES, stream) != hipSuccess) return;
    Args a{};
    for (int i = 0; i < 18; ++i) a.in[i] = (const float*)d_in[i];
    a.out = (float*)d_out; a.ws = (unsigned char*)d_ws;
#if MK_ONE_LAUNCH
    a.ph_lo = 0; a.ph_hi = N_PHASES;
    hipLaunchKernelGGL(trunk_fwd, dim3(grid), dim3(NWAVES * 64), LDS_BYTES, stream, a);
#else
    for (int p = 0; p < N_PHASES; ++p) {
        if (p >= 1 && p < N_PHASES - 1 && (p - 1) % 6 == 2) { const int l = (p - 1) / 6;
            if (USE_NAIVE_MLSTM) hipLaunchKernelGGL(k_mlstm_naive, dim3(64), dim3(512), 160000, stream, a, l);
            if (USE_NAIVE_ATTN) { hipLaunchKernelGGL(k_attn_naive, dim3(1024), dim3(512), 131072, stream, a, l); continue; } }
        a.ph_lo = p; a.ph_hi = p + 1;
        if (SPLIT_MIXERS && p >= 1 && p < N_PHASES - 1 && (p - 1) % 6 == 2) { a.mix_sel = 1; hipLaunchKernelGGL(trunk_fwd, dim3(grid), dim3(NWAVES * 64), LDS_BYTES, stream, a); a.mix_sel = 2; hipLaunchKernelGGL(trunk_fwd, dim3(grid), dim3(NWAVES * 64), LDS_BYTES, stream, a); a.mix_sel = 0; continue; }
        hipLaunchKernelGGL(trunk_fwd, dim3(grid), dim3(NWAVES * 64), LDS_BYTES, stream, a); }
#endif
}
```
